# Optimizing an MI355X kernel written in HIP

```python
import jax, jax.numpy as jnp
from jax import lax
import numpy as np

D_MODEL = 1024
BATCH = 16
SEQ = 4096
DEPTH = 1
DEC_BATCH = 2
DEC_SEQ = 8192
PAST_LEN = 128

EPS = 1e-6
POOL_WINDOWS = (2, 4, 8, 16)
N_POOL_GROUPS = len(POOL_WINDOWS)
POOL_GROUP_DIM = 128
D_POOL = N_POOL_GROUPS * POOL_GROUP_DIM
POOL_OUT_DIM = D_MODEL // N_POOL_GROUPS
CHUNK = 128
N_SGU_HEADS = 8
SGU_HEAD_DIM = 64
D_SGU = N_SGU_HEADS * SGU_HEAD_DIM
N_BRANCH = 2
D_IN = D_POOL + 2 * D_SGU + N_BRANCH * D_MODEL
D_FF = 2816
CONV_WIDTH = 3
PLE_DIM = 256

kernel_name = "hybrid_pool_sgu_encoder"


def rms_norm(x, g):
    xf = x.astype(jnp.float32)
    y = xf * lax.rsqrt(jnp.mean(xf * xf, axis=-1, keepdims=True) + EPS)
    return (y * g.astype(jnp.float32)).astype(x.dtype)


def pool_mixer(z, pool_w, pool_scale):
    B, S, _ = z.shape
    zg = z.reshape(B, S, N_POOL_GROUPS, POOL_GROUP_DIM)
    csum = jnp.cumsum(zg.astype(jnp.float32), axis=1)
    csum = jnp.concatenate([jnp.zeros_like(csum[:, :1]), csum], axis=1)
    t = jnp.arange(S, dtype=jnp.int32)
    outs = []
    for gi, w in enumerate(POOL_WINDOWS):
        lo = jnp.clip(t - w // 2, 0, S)
        hi = jnp.clip(t + w // 2, 0, S)
        cg = csum[:, :, gi]
        s = jnp.take(cg, hi, axis=1) - jnp.take(cg, lo, axis=1)
        mean = s / (hi - lo).astype(jnp.float32)[None, :, None]
        outs.append(mean - zg[:, :, gi].astype(jnp.float32))
    d = jnp.stack(outs, axis=2).astype(z.dtype)
    y = jnp.einsum('bsgc,gcd->bsgd', d, pool_w).reshape(B, S, D_MODEL)
    return y * pool_scale


def sgu_mixer(z_uv, g_v, sgu_w, sgu_b, w_gproj):
    B, S, _ = z_uv.shape
    uv = jax.nn.gelu(z_uv, approximate=False)
    u, v = jnp.split(uv, 2, axis=-1)
    v = v.reshape(B, S // CHUNK, CHUNK, N_SGU_HEADS, SGU_HEAD_DIM)
    v = rms_norm(v, g_v)
    mixed = jnp.einsum('hts,bnshc->bnthc', sgu_w, v) + sgu_b.T[:, :, None]
    gated = u * mixed.reshape(B, S, D_SGU)
    return gated @ w_gproj


def depthwise_conv_centred(a, w, b):
    ap = jnp.pad(a, ((0, 0), (1, 1), (0, 0)))
    return ap[:, :-2] * w[0] + ap[:, 1:-1] * w[1] + ap[:, 2:] * w[2] + b


def layer(x, p, g_mix, w_in, pool_w, pool_scale, g_v, sgu_w, sgu_b, w_gproj, w_o,
          g_ffn, w_up, conv_w, conv_b, w_down, g_pe, w_pe, w_pg):
    B, S, _ = x.shape
    h = rms_norm(x, g_mix)
    proj = h @ w_in
    z_pool, z_uv, gate_logits = jnp.split(proj, [D_POOL, D_POOL + 2 * D_SGU], axis=-1)
    gates = jax.nn.sigmoid(gate_logits.reshape(B, S, N_BRANCH, D_MODEL))
    a = pool_mixer(z_pool, pool_w, pool_scale)
    c = sgu_mixer(z_uv, g_v, sgu_w, sgu_b, w_gproj)
    merged = gates[:, :, 0] * a + gates[:, :, 1] * c
    x = x + merged @ w_o
    h2 = rms_norm(x, g_ffn)
    up = depthwise_conv_centred(h2 @ w_up, conv_w, conv_b)
    gate, val = jnp.split(up, 2, axis=-1)
    x = x + (jax.nn.gelu(gate, approximate=False) * val) @ w_down
    pe_gate = jax.nn.sigmoid(rms_norm(x, g_pe) @ w_pg)
    x = x + (p.astype(x.dtype) @ w_pe) * pe_gate
    return x


def encoder(x, p, g_mix, w_in, pool_w, pool_scale, g_v, sgu_w, sgu_b, w_gproj, w_o,
            g_ffn, w_up, conv_w, conv_b, w_down, g_pe, w_pe, w_pg, g_final):
    for i in range(DEPTH):
        x = layer(x, p[i], g_mix[i], w_in[i], pool_w[i], pool_scale[i], g_v[i], sgu_w[i],
                  sgu_b[i], w_gproj[i], w_o[i], g_ffn[i], w_up[i], conv_w[i], conv_b[i],
                  w_down[i], g_pe[i], w_pe[i], w_pg[i])
    return rms_norm(x, g_final)


def setup_inputs(seed: int = 0) -> dict:
    key = jax.random.key(seed)
    ks = jax.random.split(key, 24)
    f32 = jnp.float32
    L = DEPTH

    def nrm(k, shape, scale):
        return jax.random.normal(k, shape, f32) * scale

    def gain(k, shape):
        return 1.0 + 0.02 * jax.random.normal(k, shape, f32)

    return {
        "x_prompt": nrm(ks[0], (BATCH, SEQ, D_MODEL), 1.0),
        "x_sample": nrm(ks[1], (DEC_BATCH, DEC_SEQ, D_MODEL), 1.0),
        "p_prompt": nrm(ks[2], (DEPTH, BATCH, SEQ, PLE_DIM), 1.0),
        "p_sample": nrm(ks[3], (DEPTH, DEC_BATCH, DEC_SEQ, PLE_DIM), 1.0),
        "g_mix": gain(ks[4], (L, D_MODEL)),
        "w_in": nrm(ks[5], (L, D_MODEL, D_IN), D_MODEL ** -0.5),
        "pool_w": nrm(ks[6], (L, N_POOL_GROUPS, POOL_GROUP_DIM, POOL_OUT_DIM), POOL_GROUP_DIM ** -0.5),
        "pool_scale": gain(ks[7], (L, D_MODEL)),
        "g_v": gain(ks[8], (L, N_SGU_HEADS, SGU_HEAD_DIM)),
        "sgu_w": nrm(ks[9], (L, N_SGU_HEADS, CHUNK, CHUNK), CHUNK ** -0.5),
        "sgu_b": 1.0 + 0.01 * jax.random.normal(ks[10], (L, N_SGU_HEADS, CHUNK), f32),
        "w_gproj": nrm(ks[11], (L, D_SGU, D_MODEL), D_SGU ** -0.5),
        "w_o": nrm(ks[12], (L, D_MODEL, D_MODEL), D_MODEL ** -0.5),
        "g_ffn": gain(ks[13], (L, D_MODEL)),
        "w_up": nrm(ks[14], (L, D_MODEL, 2 * D_FF), D_MODEL ** -0.5),
        "conv_w": nrm(ks[15], (L, CONV_WIDTH, 2 * D_FF), CONV_WIDTH ** -0.5),
        "conv_b": nrm(ks[16], (L, 2 * D_FF), 0.01),
        "w_down": nrm(ks[17], (L, D_FF, D_MODEL), D_FF ** -0.5),
        "g_pe": gain(ks[18], (L, D_MODEL)),
        "w_pe": nrm(ks[19], (L, PLE_DIM, D_MODEL), PLE_DIM ** -0.5),
        "w_pg": nrm(ks[20], (L, D_MODEL, D_MODEL), D_MODEL ** -0.5),
        "g_final": gain(ks[21], (D_MODEL,)),
    }


def reference(x_prompt, x_sample, p_prompt, p_sample, g_mix, w_in, pool_w, pool_scale, g_v,
              sgu_w, sgu_b, w_gproj, w_o, g_ffn, w_up, conv_w, conv_b, w_down, g_pe, w_pe,
              w_pg, g_final):
    y_prompt = encoder(x_prompt, p_prompt, g_mix, w_in, pool_w, pool_scale, g_v, sgu_w, sgu_b,
                       w_gproj, w_o, g_ffn, w_up, conv_w, conv_b, w_down, g_pe, w_pe, w_pg, g_final)
    y_sample = encoder(x_sample, p_sample, g_mix, w_in, pool_w, pool_scale, g_v, sgu_w, sgu_b,
                       w_gproj, w_o, g_ffn, w_up, conv_w, conv_b, w_down, g_pe, w_pe, w_pg, g_final)
    return (y_prompt, y_sample)
```

```cpp
#include <hip/hip_runtime.h>
#include <hip/hip_cooperative_groups.h>
#include <cstdio>
#include <cstdint>
namespace cg = cooperative_groups;

#define LAS __attribute__((address_space(3)))
typedef unsigned short bf16_t;
typedef short bf16x8 __attribute__((ext_vector_type(8)));
typedef float f32x4 __attribute__((ext_vector_type(4)));
typedef float f32x2 __attribute__((ext_vector_type(2)));
typedef unsigned u32x4 __attribute__((ext_vector_type(4)));
typedef unsigned u32x2 __attribute__((ext_vector_type(2)));

constexpr int T = 81920, TP = 65536, D = 1024, DIN = 3584, DFF = 2816, NUP = 5632, PLE = 256;
constexpr float EPS = 1e-6f;
constexpr int NPH = 8;
constexpr size_t MiB = 1u << 20;
constexpr size_t WS_R1 = 0, WS_SSQ2 = WS_R1 + (size_t)T * 4, WS_SSQ3 = WS_SSQ2 + (size_t)T * 4, WS_SSQ4 = WS_SSQ3 + (size_t)T * 4;
constexpr size_t WS_CNT = WS_SSQ4 + (size_t)T * 4;
constexpr size_t WS_BAR = 1536 * 1024;
constexpr size_t WS_WIN = 2 * MiB;
constexpr size_t WS_WUP = WS_WIN + (size_t)DIN * D * 2;
constexpr size_t WS_WDN = WS_WUP + (size_t)NUP * D * 2;
constexpr size_t WS_WO = WS_WDN + (size_t)D * DFF * 2;
constexpr size_t WS_WPG = WS_WO + (size_t)D * D * 2;
constexpr size_t WS_WPE = WS_WPG + (size_t)D * D * 2;
constexpr size_t WS_WGP = WS_WPE + (size_t)D * PLE * 2;
constexpr size_t WS_POOLT = WS_WGP + (size_t)D * 512 * 2;
constexpr size_t WS_SGUW = WS_POOLT + (size_t)4 * 256 * 128 * 2;
constexpr size_t WS_PB = 32 * MiB;
constexpr size_t WS_XB = 73 * MiB;
constexpr size_t WS_MG = 234 * MiB;
constexpr size_t WS_PROJ = 394 * MiB;
constexpr size_t WS_END = 954 * MiB;
static_assert(WS_SGUW + 8 * 128 * 128 * 2 <= WS_PB && WS_CNT + 320 * 256 <= WS_BAR, "weights / control words fit");

namespace pg8 {
constexpr int BM = 256, BK = 64, HALF = 128, HTB = HALF * BK * 2, STAGE_BYTES = 8 * HTB, NXCD = 8, WGM = 8;
__host__ __device__ __forceinline__ int lds_byte(int r, int c) { const int st = (r >> 4) * 2 + (c >> 5), rr = r & 15, cc = c & 31, ob = rr * 64 + cc * 2; return st * 1024 + (ob ^ (((ob >> 9) & 1) << 5)); }
__host__ __device__ __forceinline__ void stage_rc(int b, int& R, int& C) { const int st = b / 1024, sb = b % 1024, swz = sb ^ (((sb >> 9) & 1) << 5); R = (st >> 1) * 16 + swz / 64; C = (st & 1) * 32 + (swz % 64) / 2; }
__host__ __device__ __forceinline__ int perm32(int rho) { const int n = rho >> 4, i = rho & 15; return 8 * (i >> 2) + 4 * n + (i & 3); }

struct Unit { int pm, pn; };
struct Gemm { const bf16_t* A; const bf16_t* Bt; int K; int seg; };
__host__ __device__ __forceinline__ int seg_bt(int s) { const int sg = s / 65, j = s - 65 * sg; return 8192 * sg + 126 * j; }

struct StaticOrder {
    int nM, nN, nwg, G, c;
    __host__ __device__ void init(int nM_, int nN_, int G_, int c_) { nM = nM_; nN = nN_; nwg = nM * nN; G = G_; c = c_; }
    __host__ __device__ bool next(int i, Unit& u) const {
        const long L = (long)i * G + c; if (L >= nwg) return false;
        int wgid = (int)L; { const int q = nwg / NXCD, r = nwg % NXCD, xcd = wgid % NXCD, off = wgid / NXCD; wgid = (xcd < r ? xcd * (q + 1) : r * (q + 1) + (xcd - r) * q) + off; }
        const int nig = WGM * nN, gid = wgid / nig, fm = gid * WGM, gsz = (nM - fm) < WGM ? (nM - fm) : WGM;
        u.pm = fm + ((wgid % nig) % gsz); u.pn = (wgid % nig) / gsz; return true;
    }
    __device__ __forceinline__ void a_ready(const Unit&) const {}
    __device__ __forceinline__ void done(const Unit&) const {}
};

__device__ __forceinline__ unsigned cvt_pk_bf16(float lo, float hi) { unsigned r; asm volatile("v_cvt_pk_bf16_f32 %0, %1, %2" : "=v"(r) : "v"(lo), "v"(hi)); return r; }
__device__ __forceinline__ f32x2 gelu_pk(f32x2 v) {
    f32x2 z = v * 0.70710678118f;
    z.x = __builtin_amdgcn_fmed3f(z.x, -3.832506856900711f, 3.832506856900711f); z.y = __builtin_amdgcn_fmed3f(z.y, -3.832506856900711f, 3.832506856900711f);
    const f32x2 z2 = z * z;
    f32x2 p = z2 * 0.00022905065861350646f + 0.0034082910107109506f; p = p * z2 + 0.050955695062380861f; p = p * z2 + 0.18520832239976145f; p = p * z2 + 1.128379143519084f;
    f32x2 q = z2 * -1.1791602954361697e-7f + 0.000023547966471313185f; q = q * z2 + 0.0010179625278914885f; q = q * z2 + 0.014070470171167667f; q = q * z2 + 0.11098505178285362f; q = q * z2 + 0.49746925110067538f; q = q * z2 + 1.0f;
    f32x2 r; r.x = __builtin_amdgcn_rcpf(q.x); r.y = __builtin_amdgcn_rcpf(q.y);
    const f32x2 e = (z * p) * r, hv = v * 0.5f;
    return hv * e + hv;
}
__device__ __forceinline__ f32x4 gelu4(f32x4 v) { const f32x2 a = gelu_pk((f32x2){v[0], v[1]}), b = gelu_pk((f32x2){v[2], v[3]}); return (f32x4){a.x, a.y, b.x, b.y}; }
__device__ __forceinline__ float sigm(float x) { return __builtin_amdgcn_rcpf(1.0f + __builtin_amdgcn_exp2f(x * -1.44269504089f)); }
__device__ __forceinline__ f32x4 sigm4(f32x4 v) { return (f32x4){sigm(v[0]), sigm(v[1]), sigm(v[2]), sigm(v[3])}; }
__device__ __forceinline__ float sigp(float y) { return __builtin_amdgcn_rcpf(1.0f + __builtin_amdgcn_exp2f(y)); }
__device__ __forceinline__ f32x4 sigp4(f32x4 v) { return (f32x4){sigp(v[0]), sigp(v[1]), sigp(v[2]), sigp(v[3])}; }
__device__ __forceinline__ float bf_lo(unsigned w) { return __uint_as_float(w << 16); }
__device__ __forceinline__ float bf_hi(unsigned w) { return __uint_as_float(w & 0xffff0000u); }

template <class Epi, class Sched, bool ALIGN_EPI = false, bool SP2 = false>
__device__ __forceinline__ void gemm_phase(LAS unsigned char* lds, const Gemm g, const Sched& S, const Epi& E) {
    const int tid = threadIdx.x, wid = __builtin_amdgcn_readfirstlane(tid >> 6), lane = tid & 63, wr = wid >> 2, wc = wid & 3, fr = lane & 15, fq = lane >> 4;
    const int K = g.K, nt = K / BK;
    unsigned voffA[2], voffB[2];
#pragma unroll
    for (int i = 0; i < 2; ++i) { int R, C; stage_rc(tid * 16 + i * 8192, R, C); const int Rb = Epi::PERM ? ((R & ~31) + perm32(R & 31)) : R;
        const int Ra = g.seg ? (8 * (R & 15) + ((R >> 4) & 3)) : (R & 63);
        voffA[i] = (unsigned)(Ra * K + C) * 2u; voffB[i] = (unsigned)(Rb * K + C) * 2u; }
    const size_t kstep = (size_t)(BK * 2);
    const size_t hstep = (size_t)HALF * K * 2;
    const size_t tstep = 2 * hstep;
    const size_t rowb = (size_t)K * 2;
    const size_t hstepA = (g.seg ? 4 : 128) * rowb;
#define PG8_ABASE(pm_) ((const char*)g.A + (size_t)(g.seg ? seg_bt(2 * (pm_)) : 256 * (pm_)) * rowb)
#define PG8_AGAP(pm_) ((size_t)(g.seg ? (seg_bt(2 * (pm_) + 1) - seg_bt(2 * (pm_))) : 64) * rowb)
    const unsigned ldsw = (unsigned)wid * 1024u;
    const int aoff = lds_byte(wr * 64 + fr, fq * 8), boff = lds_byte(wc * 32 + fr, fq * 8);
#define PG8_SA(b, h) (((b) * 2 + (h)) * HTB)
#define PG8_SB(b, h) ((4 + (b) * 2 + (h)) * HTB)
#define PG8_STAGE(bufoff, gbase, voff) do { _Pragma("unroll") for (int _i = 0; _i < 2; ++_i) \
        __builtin_amdgcn_global_load_lds((const unsigned*)((const char*)(gbase) + (voff)[_i]), (LAS unsigned*)(lds + (bufoff) + ldsw + _i * 8192), 16, 0, 0); } while (0)
#define PG8_STAGE_A(bufoff, gbase, gapb) do { _Pragma("unroll") for (int _i = 0; _i < 2; ++_i) \
        __builtin_amdgcn_global_load_lds((const unsigned*)((const char*)(gbase) + (size_t)_i * (gapb) + voffA[_i]), (LAS unsigned*)(lds + (bufoff) + ldsw + _i * 8192), 16, 0, 0); } while (0)
#define PG8_LDA(dst, b, h) do { _Pragma("unroll") for (int m = 0; m < 4; ++m) _Pragma("unroll") for (int k = 0; k < 2; ++k) dst[m][k] = *(const LAS bf16x8*)(lds + PG8_SA(b, h) + aoff + m * 2048 + k * 1024); } while (0)
#define PG8_LDB(dst, b, h) do { _Pragma("unroll") for (int n = 0; n < 2; ++n) _Pragma("unroll") for (int k = 0; k < 2; ++k) dst[n][k] = *(const LAS bf16x8*)(lds + PG8_SB(b, h) + boff + n * 2048 + k * 1024); } while (0)
#define PG8_MMA(ai, bj, At, Bt) do { __builtin_amdgcn_s_setprio(1); _Pragma("unroll") for (int m = 0; m < 4; ++m) _Pragma("unroll") for (int n = 0; n < 2; ++n) _Pragma("unroll") for (int k = 0; k < 2; ++k) \
        acc[ai][bj][m][n] = __builtin_amdgcn_mfma_f32_16x16x32_bf16(Bt[n][k], At[m][k], acc[ai][bj][m][n], 0, 0, 0); __builtin_amdgcn_s_setprio(0); } while (0)
#define PG8_WAIT_V(n) asm volatile("s_waitcnt vmcnt(" #n ")" ::: "memory")
#define PG8_WAIT_L(n) asm volatile("s_waitcnt lgkmcnt(" #n ")" ::: "memory")
#define PG8_BAR __builtin_amdgcn_s_barrier()
#define PG8_SCHED __builtin_amdgcn_sched_barrier(0)
    Unit cur, nxt; int ui = 0;
    if (!S.next(0, cur)) return;
    f32x4 acc[2][2][4][2];
#pragma unroll
    for (int a = 0; a < 2; ++a)
#pragma unroll
        for (int b = 0; b < 2; ++b)
#pragma unroll
            for (int m = 0; m < 4; ++m)
#pragma unroll
                for (int n = 0; n < 2; ++n) acc[a][b][m][n] = (f32x4){0.f, 0.f, 0.f, 0.f};
    bf16x8 At[4][2], B0[2][2], B1[2][2];
    const char* cA = PG8_ABASE(cur.pm); size_t cG = PG8_AGAP(cur.pm); const char* cB = (const char*)g.Bt + (size_t)cur.pn * tstep;
    S.a_ready(cur);
    if constexpr (SP2) {
        PG8_STAGE(PG8_SB(0, 0), cB, voffB); PG8_STAGE(PG8_SB(0, 1), cB + hstep, voffB); PG8_STAGE_A(PG8_SA(0, 0), cA, cG); PG8_STAGE_A(PG8_SA(0, 1), cA + hstepA, cG);
        if (wr == 1) PG8_BAR;
        PG8_WAIT_V(2); PG8_BAR;
        PG8_STAGE(PG8_SB(1, 0), cB + kstep, voffB); PG8_STAGE_A(PG8_SA(1, 0), cA + kstep, cG); PG8_STAGE(PG8_SB(1, 1), cB + hstep + kstep, voffB);
        PG8_WAIT_V(6); PG8_BAR;
    } else {
        PG8_STAGE(PG8_SB(0, 0), cB, voffB); PG8_STAGE_A(PG8_SA(0, 0), cA, cG); PG8_STAGE(PG8_SB(0, 1), cB + hstep, voffB); PG8_STAGE_A(PG8_SA(0, 1), cA + hstepA, cG);
        if (wr == 1) PG8_BAR;
        PG8_WAIT_V(4); PG8_BAR;
        PG8_STAGE(PG8_SB(1, 0), cB + kstep, voffB); PG8_STAGE_A(PG8_SA(1, 0), cA + kstep, cG); PG8_STAGE(PG8_SB(1, 1), cB + hstep + kstep, voffB);
        PG8_WAIT_V(6); PG8_BAR;
    }
    for (;;) {
        const bool has_next = S.next(ui + 1, nxt);
        const char* nA = has_next ? PG8_ABASE(nxt.pm) : cA; const size_t nG = has_next ? PG8_AGAP(nxt.pm) : cG; const char* nB = has_next ? (const char*)g.Bt + (size_t)nxt.pn * tstep : cB;
#pragma unroll 1
        for (int t = 0; t < nt; t += 2) {
            const bool last = (t == nt - 2);
            const char* a1 = cA + (size_t)(t + 1) * kstep;
            const char* a2 = last ? nA : cA + (size_t)(t + 2) * kstep; const char* b2 = last ? nB : cB + (size_t)(t + 2) * kstep;
            const char* a3 = a2 + kstep; const char* b3 = b2 + kstep; const size_t g2 = last ? nG : cG;
            if (last && has_next) S.a_ready(nxt);
            if constexpr (SP2) {
            PG8_LDB(B0, 0, 0); PG8_LDB(B1, 0, 1); PG8_SCHED; PG8_LDA(At, 0, 0); PG8_STAGE_A(PG8_SA(1, 1), a1 + hstepA, cG);
            PG8_WAIT_V(8); PG8_WAIT_L(0); PG8_BAR; PG8_MMA(0, 0, At, B0); PG8_MMA(0, 1, At, B1); PG8_BAR; PG8_SCHED;
            PG8_LDA(At, 0, 1); PG8_STAGE(PG8_SB(0, 0), b2, voffB); PG8_STAGE(PG8_SB(0, 1), b2 + hstep, voffB); PG8_STAGE_A(PG8_SA(0, 0), a2, g2);
            PG8_WAIT_V(8); PG8_WAIT_L(0); PG8_BAR; PG8_MMA(1, 0, At, B0); PG8_MMA(1, 1, At, B1); PG8_BAR; PG8_SCHED;
            PG8_LDB(B0, 1, 0); PG8_LDB(B1, 1, 1); PG8_SCHED; PG8_LDA(At, 1, 0); PG8_STAGE_A(PG8_SA(0, 1), a2 + hstepA, g2);
            PG8_WAIT_V(8); PG8_WAIT_L(0); PG8_BAR; PG8_MMA(0, 0, At, B0); PG8_MMA(0, 1, At, B1); PG8_BAR; PG8_SCHED;
            PG8_LDA(At, 1, 1); PG8_STAGE(PG8_SB(1, 0), b3, voffB); PG8_STAGE(PG8_SB(1, 1), b3 + hstep, voffB); PG8_STAGE_A(PG8_SA(1, 0), a3, g2);
            PG8_WAIT_V(8); PG8_WAIT_L(0); PG8_BAR; PG8_MMA(1, 0, At, B0); PG8_MMA(1, 1, At, B1); PG8_BAR; PG8_SCHED;
            } else {
            PG8_LDB(B0, 0, 0); PG8_SCHED; PG8_LDA(At, 0, 0); PG8_STAGE_A(PG8_SA(1, 1), a1 + hstepA, cG);
            PG8_WAIT_L(8); PG8_BAR; PG8_WAIT_L(0); PG8_MMA(0, 0, At, B0); PG8_BAR; PG8_SCHED;
            PG8_LDB(B1, 0, 1); PG8_STAGE(PG8_SB(0, 0), b2, voffB);
            PG8_BAR; PG8_WAIT_L(0); PG8_MMA(0, 1, At, B1); PG8_BAR;
            PG8_LDA(At, 0, 1); PG8_STAGE_A(PG8_SA(0, 0), a2, g2);
            PG8_BAR; PG8_WAIT_L(0); PG8_MMA(1, 0, At, B0); PG8_BAR; PG8_SCHED;
            PG8_STAGE(PG8_SB(0, 1), b2 + hstep, voffB);
            PG8_WAIT_V(6); PG8_BAR; PG8_MMA(1, 1, At, B1); PG8_BAR;
            PG8_LDB(B0, 1, 0); PG8_SCHED; PG8_LDA(At, 1, 0); PG8_STAGE_A(PG8_SA(0, 1), a2 + hstepA, g2);
            PG8_WAIT_L(8); PG8_BAR; PG8_WAIT_L(0); PG8_MMA(0, 0, At, B0); PG8_BAR; PG8_SCHED;
            PG8_LDB(B1, 1, 1); PG8_STAGE(PG8_SB(1, 0), b3, voffB);
            PG8_BAR; PG8_WAIT_L(0); PG8_MMA(0, 1, At, B1); PG8_BAR;
            PG8_LDA(At, 1, 1); PG8_STAGE_A(PG8_SA(1, 0), a3, g2);
            PG8_BAR; PG8_WAIT_L(0); PG8_MMA(1, 0, At, B0); PG8_BAR; PG8_SCHED;
            PG8_STAGE(PG8_SB(1, 1), b3 + hstep, voffB);
            PG8_WAIT_V(6); PG8_BAR; PG8_MMA(1, 1, At, B1); PG8_BAR;
            }
        }
        if constexpr (ALIGN_EPI) { if (wr == 0) PG8_BAR; }
        E(acc, cur, wr, wc, fr, fq); S.done(cur);
        if (!has_next) break;
#pragma unroll
        for (int a = 0; a < 2; ++a)
#pragma unroll
            for (int b = 0; b < 2; ++b)
#pragma unroll
                for (int m = 0; m < 4; ++m)
#pragma unroll
                    for (int n = 0; n < 2; ++n) acc[a][b][m][n] = (f32x4){0.f, 0.f, 0.f, 0.f};
        cur = nxt; cA = nA; cG = nG; cB = nB; ++ui;
        if constexpr (ALIGN_EPI) { if (wr == 1) PG8_BAR; }
    }
    PG8_WAIT_V(0);
    if constexpr (!ALIGN_EPI) { if (wr == 0) PG8_BAR; }
    PG8_BAR;
#undef PG8_SA
#undef PG8_STAGE_A
#undef PG8_ABASE
#undef PG8_AGAP
#undef PG8_SB
#undef PG8_STAGE
#undef PG8_LDA
#undef PG8_LDB
#undef PG8_MMA
#undef PG8_WAIT_V
#undef PG8_WAIT_L
#undef PG8_BAR
#undef PG8_SCHED
}


struct EpiProj {
    static constexpr bool PERM = true;
    bf16_t* O; const float* r1; const float* gv;
    __device__ __forceinline__ void operator()(const f32x4 (&acc)[2][2][4][2], const Unit& u, int wr, int wc, int fr, int fq) const {
        const int row0 = u.pm * BM + wr * 64 + fr, pn = u.pn;
        const int mode = pn < 2 ? 0 : (pn < 4 ? 1 : (pn < 6 ? 2 : 3));
        if (mode == 2) {
            const int h = 4 * (pn - 4) + wc;
            f32x4 g[2][2];
#pragma unroll
            for (int bj = 0; bj < 2; ++bj)
#pragma unroll
                for (int n = 0; n < 2; ++n) g[bj][n] = *(const f32x4*)(gv + h * 64 + 32 * bj + 8 * fq + 4 * n);
#pragma unroll
            for (int ai = 0; ai < 2; ++ai)
#pragma unroll
                for (int m = 0; m < 4; ++m) {
                    const int row = row0 + ai * HALF + m * 16; const float rs = r1[row];
                    f32x4 v[2][2]; float ss = 0.f;
#pragma unroll
                    for (int bj = 0; bj < 2; ++bj)
#pragma unroll
                        for (int n = 0; n < 2; ++n) { v[bj][n] = gelu4(acc[ai][bj][m][n] * rs); const f32x4 q = v[bj][n] * v[bj][n]; ss += (q[0] + q[1]) + (q[2] + q[3]); }
                    ss += __shfl_xor(ss, 16); ss += __shfl_xor(ss, 32);
                    const float ri = __builtin_amdgcn_rsqf(ss * (1.0f / 64.0f) + EPS);
                    bf16_t* rowp = O + (size_t)row * DIN + pn * BM + 64 * wc + 8 * fq;
#pragma unroll
                    for (int bj = 0; bj < 2; ++bj) { const f32x4 a = v[bj][0] * ri * g[bj][0], b = v[bj][1] * ri * g[bj][1];
                        u32x4 w; w.x = cvt_pk_bf16(a[0], a[1]); w.y = cvt_pk_bf16(a[2], a[3]); w.z = cvt_pk_bf16(b[0], b[1]); w.w = cvt_pk_bf16(b[2], b[3]);
                        *(u32x4*)(rowp + 32 * bj) = w; }
                }
        } else {
#pragma unroll
            for (int ai = 0; ai < 2; ++ai)
#pragma unroll
                for (int m = 0; m < 4; ++m) {
                    const int row = row0 + ai * HALF + m * 16; const float rs = r1[row];
                    bf16_t* rowp = O + (size_t)row * DIN + pn * BM + 32 * wc + 8 * fq;
                    const float rq = (mode == 3) ? rs * -1.44269504089f : rs;
#pragma unroll
                    for (int bj = 0; bj < 2; ++bj) { f32x4 a = acc[ai][bj][m][0] * rq, b = acc[ai][bj][m][1] * rq;
                        if (mode == 1) { a = gelu4(a); b = gelu4(b); } else if (mode == 3) { a = sigp4(a); b = sigp4(b); }
                        u32x4 w; w.x = cvt_pk_bf16(a[0], a[1]); w.y = cvt_pk_bf16(a[2], a[3]); w.z = cvt_pk_bf16(b[0], b[1]); w.w = cvt_pk_bf16(b[2], b[3]);
                        *(u32x4*)(rowp + HALF * bj) = w; }
                }
        }
    }
};

struct EpiMerge {
    static constexpr bool PERM = true;
    bf16_t* AG; const bf16_t* PROJ;
    __device__ __forceinline__ void operator()(const f32x4 (&acc)[2][2][4][2], const Unit& u, int wr, int wc, int fr, int fq) const {
        const int row0 = u.pm * BM + wr * 64 + fr, col0 = u.pn * BM + 32 * wc + 8 * fq;
#pragma unroll
        for (int ai = 0; ai < 2; ++ai)
#pragma unroll
            for (int m = 0; m < 4; ++m) {
                const int row = row0 + ai * HALF + m * 16;
#pragma unroll
                for (int bj = 0; bj < 2; ++bj) {
                    bf16_t* ap = AG + (size_t)row * D + col0 + HALF * bj;
                    const u32x4 a = *(const u32x4*)ap, g = *(const u32x4*)(PROJ + (size_t)row * DIN + 2560 + col0 + HALF * bj);
                    const f32x4 c0 = acc[ai][bj][m][0], c1 = acc[ai][bj][m][1];
                    u32x4 w;
                    w.x = cvt_pk_bf16(bf_lo(a.x) + bf_lo(g.x) * c0[0], bf_hi(a.x) + bf_hi(g.x) * c0[1]);
                    w.y = cvt_pk_bf16(bf_lo(a.y) + bf_lo(g.y) * c0[2], bf_hi(a.y) + bf_hi(g.y) * c0[3]);
                    w.z = cvt_pk_bf16(bf_lo(a.z) + bf_lo(g.z) * c1[0], bf_hi(a.z) + bf_hi(g.z) * c1[1]);
                    w.w = cvt_pk_bf16(bf_lo(a.w) + bf_lo(g.w) * c1[2], bf_hi(a.w) + bf_hi(g.w) * c1[3]);
                    *(u32x4*)ap = w; }
            }
    }
};

struct EpiRes {
    static constexpr bool PERM = true;
    bf16_t* xb; float* ssq;
    __device__ __forceinline__ void operator()(const f32x4 (&acc)[2][2][4][2], const Unit& u, int wr, int wc, int fr, int fq) const {
        const int row0 = u.pm * BM + wr * 64 + fr, col0 = u.pn * BM + 32 * wc + 8 * fq;
#pragma unroll
        for (int ai = 0; ai < 2; ++ai)
#pragma unroll
            for (int m = 0; m < 4; ++m) {
                const int row = row0 + ai * HALF + m * 16;
                bf16_t* rp = xb + (size_t)row * D + col0;
                float ss = 0.f;
#pragma unroll
                for (int bj = 0; bj < 2; ++bj) {
                    const u32x4 b = *(const u32x4*)(rp + HALF * bj);
                    const f32x4 c0 = acc[ai][bj][m][0], c1 = acc[ai][bj][m][1];
                    const float x0 = bf_lo(b.x) + c0[0], x1 = bf_hi(b.x) + c0[1], x2 = bf_lo(b.y) + c0[2], x3 = bf_hi(b.y) + c0[3];
                    const float x4 = bf_lo(b.z) + c1[0], x5 = bf_hi(b.z) + c1[1], x6 = bf_lo(b.w) + c1[2], x7 = bf_hi(b.w) + c1[3];
                    ss += ((x0 * x0 + x1 * x1) + (x2 * x2 + x3 * x3)) + ((x4 * x4 + x5 * x5) + (x6 * x6 + x7 * x7));
                    u32x4 w; w.x = cvt_pk_bf16(x0, x1); w.y = cvt_pk_bf16(x2, x3); w.z = cvt_pk_bf16(x4, x5); w.w = cvt_pk_bf16(x6, x7);
                    *(u32x4*)(rp + HALF * bj) = w; }
                ss += __shfl_xor(ss, 16); ss += __shfl_xor(ss, 32);
                if (fq == 0) (void)__hip_atomic_fetch_add(ssq + row, ss, __ATOMIC_RELAXED, __HIP_MEMORY_SCOPE_AGENT);
            }
    }
};

__device__ __forceinline__ float dpp_ror1(float v) { return __int_as_float(__builtin_amdgcn_update_dpp(__float_as_int(v), __float_as_int(v), 0x121, 0xf, 0xf, false)); }
__device__ __forceinline__ float dpp_ror15(float v) { return __int_as_float(__builtin_amdgcn_update_dpp(__float_as_int(v), __float_as_int(v), 0x12F, 0xf, 0xf, false)); }
__device__ __forceinline__ f32x2 ror1_2(f32x2 v) { return (f32x2){dpp_ror1(v.x), dpp_ror1(v.y)}; }
__device__ __forceinline__ f32x2 ror15_2(f32x2 v) { return (f32x2){dpp_ror15(v.x), dpp_ror15(v.y)}; }
struct EpiUp {
    static constexpr bool PERM = true;
    bf16_t* G; const float* ssq2; const float* cw; const float* cb;
    struct CW { f32x2 g0, g1, g2, gb, v0, v1, v2, vb; };
    __device__ __forceinline__ void ldw(CW& w, int c) const {
        w.g0 = *(const f32x2*)(cw + c); w.g1 = *(const f32x2*)(cw + NUP + c); w.g2 = *(const f32x2*)(cw + 2 * NUP + c); w.gb = *(const f32x2*)(cb + c);
        w.v0 = *(const f32x2*)(cw + DFF + c); w.v1 = *(const f32x2*)(cw + NUP + DFF + c); w.v2 = *(const f32x2*)(cw + 2 * NUP + DFF + c); w.vb = *(const f32x2*)(cb + DFF + c); }
    static __device__ __forceinline__ float shr1(float v) { return __int_as_float(__builtin_amdgcn_update_dpp(0, __float_as_int(v), 0x111, 0xf, 0xf, true)); }
    static __device__ __forceinline__ float shl1(float v) { return __int_as_float(__builtin_amdgcn_update_dpp(0, __float_as_int(v), 0x101, 0xf, 0xf, true)); }
    __device__ __forceinline__ void operator()(const f32x4 (&acc)[2][2][4][2], const Unit& u, int wr, int wc, int fr, int fq) const {
        const int s_ = 2 * u.pm + wr, sg = s_ / 65, j = s_ - 65 * sg;
        const int tokb = 8192 * sg + 126 * j + 8 * fr;
        const int rlo = (j == 0) ? 0 : 1, rhi = (j == 64) ? 127 : 126;
        const bool mid = (j == 32) && (sg < 8), mz7 = mid && (fr == 7), mz8 = mid && (fr == 8);
        const int gcol = HALF * u.pn + 32 * wc + 8 * fq;
        CW wa, wb; ldw(wa, gcol);
        float rs[8];
#pragma unroll
        for (int blk = 0; blk < 8; ++blk) rs[blk] = __builtin_amdgcn_rsqf(ssq2[tokb + blk] * (1.0f / D) + EPS);
        unsigned outp[8][4];
        const f32x2 z2 = (f32x2){0.f, 0.f};
#pragma unroll
        for (int it = 0; it < 4; ++it) {
            const int n = it >> 1, ip = it & 1;
            if (it < 3) { if (it & 1) ldw(wa, gcol + 4 * ((it + 1) >> 1) + 2 * ((it + 1) & 1)); else ldw(wb, gcol + 4 * ((it + 1) >> 1) + 2 * ((it + 1) & 1)); }
            __builtin_amdgcn_sched_barrier(0);
            const CW& w = (it & 1) ? wb : wa;
#define UG(b_) ((f32x2){acc[(b_) >> 2][0][(b_) & 3][n][2 * ip], acc[(b_) >> 2][0][(b_) & 3][n][2 * ip + 1]} * rs[b_])
#define UV(b_) ((f32x2){acc[(b_) >> 2][1][(b_) & 3][n][2 * ip], acc[(b_) >> 2][1][(b_) & 3][n][2 * ip + 1]} * rs[b_])
            const f32x2 ug0 = UG(0), uv0 = UV(0), ug7 = UG(7), uv7 = UV(7);
            f32x2 pg = (f32x2){shr1(ug7.x), shr1(ug7.y)}, pv = (f32x2){shr1(uv7.x), shr1(uv7.y)};
            f32x2 eg = (f32x2){shl1(ug0.x), shl1(ug0.y)}, ev = (f32x2){shl1(uv0.x), shl1(uv0.y)};
            pg = mz8 ? z2 : pg; pv = mz8 ? z2 : pv; eg = mz7 ? z2 : eg; ev = mz7 ? z2 : ev;
            f32x2 cgu = ug0, cvu = uv0;
#pragma unroll
            for (int blk = 0; blk < 8; ++blk) {
                f32x2 ng, nv;
                if (blk < 7) { ng = UG(blk + 1); nv = UV(blk + 1); } else { ng = eg; nv = ev; }
                const f32x2 cgv = w.g2 * ng + (w.g1 * cgu + (w.g0 * pg + w.gb));
                const f32x2 cvv = w.v2 * nv + (w.v1 * cvu + (w.v0 * pv + w.vb));
                const f32x2 o = gelu_pk(cgv) * cvv;
                outp[blk][it] = cvt_pk_bf16(o.x, o.y);
                pg = cgu; pv = cvu; cgu = ng; cvu = nv;
            }
#undef UG
#undef UV
        }
#pragma unroll
        for (int blk = 0; blk < 8; ++blk) { const int rho = 8 * fr + blk;
            if (rho >= rlo && rho <= rhi) { u32x4 w4; w4.x = outp[blk][0]; w4.y = outp[blk][1]; w4.z = outp[blk][2]; w4.w = outp[blk][3];
                *(u32x4*)(G + (size_t)(tokb + blk) * DFF + gcol) = w4; } }
    }
};

struct EpiBf {
    static constexpr bool PERM = true;
    bf16_t* O;
    __device__ __forceinline__ void operator()(const f32x4 (&acc)[2][2][4][2], const Unit& u, int wr, int wc, int fr, int fq) const {
        const int row0 = u.pm * BM + wr * 64 + fr, col0 = u.pn * BM + 32 * wc + 8 * fq;
#pragma unroll
        for (int ai = 0; ai < 2; ++ai)
#pragma unroll
            for (int m = 0; m < 4; ++m) { bf16_t* rowp = O + (size_t)(row0 + ai * HALF + m * 16) * D + col0;
#pragma unroll
                for (int bj = 0; bj < 2; ++bj) { const f32x4 a = acc[ai][bj][m][0], b = acc[ai][bj][m][1];
                    u32x4 w; w.x = cvt_pk_bf16(a[0], a[1]); w.y = cvt_pk_bf16(a[2], a[3]); w.z = cvt_pk_bf16(b[0], b[1]); w.w = cvt_pk_bf16(b[2], b[3]);
                    *(u32x4*)(rowp + HALF * bj) = w; }
                asm volatile("" ::: "memory"); }
    }
};

struct EpiPg {
    static constexpr bool PERM = true;
    const bf16_t* X2; const bf16_t* PEMB; float* out; const float* ssq3; float* ssq4; unsigned* cnt; const float* gf;
    __device__ __forceinline__ void operator()(const f32x4 (&acc)[2][2][4][2], const Unit& u, int wr, int wc, int fr, int fq) const {
        const int row0 = u.pm * BM + wr * 64 + fr, col0 = u.pn * BM + 32 * wc + 8 * fq;
        f32x4 x[2][4][2][2];
#pragma unroll
        for (int ai = 0; ai < 2; ++ai)
#pragma unroll
            for (int m = 0; m < 4; ++m) {
                const int row = row0 + ai * HALF + m * 16;
                const float r3 = __builtin_amdgcn_rsqf(ssq3[row] * (1.0f / D) + EPS) * -1.44269504089f;
                float ss = 0.f;
#pragma unroll
                for (int bj = 0; bj < 2; ++bj) {
                    const size_t off = (size_t)row * D + col0 + HALF * bj;
                    const u32x4 pe = *(const u32x4*)(PEMB + off), b = *(const u32x4*)(X2 + off);
                    const f32x4 g0 = sigp4(acc[ai][bj][m][0] * r3), g1 = sigp4(acc[ai][bj][m][1] * r3);
                    const f32x4 a0 = (f32x4){bf_lo(b.x) + bf_lo(pe.x) * g0[0], bf_hi(b.x) + bf_hi(pe.x) * g0[1], bf_lo(b.y) + bf_lo(pe.y) * g0[2], bf_hi(b.y) + bf_hi(pe.y) * g0[3]};
                    const f32x4 a1 = (f32x4){bf_lo(b.z) + bf_lo(pe.z) * g1[0], bf_hi(b.z) + bf_hi(pe.z) * g1[1], bf_lo(b.w) + bf_lo(pe.w) * g1[2], bf_hi(b.w) + bf_hi(pe.w) * g1[3]};
                    x[ai][m][bj][0] = a0; x[ai][m][bj][1] = a1;
                    const f32x4 q0 = a0 * a0, q1 = a1 * a1; ss += ((q0[0] + q0[1]) + (q0[2] + q0[3])) + ((q1[0] + q1[1]) + (q1[2] + q1[3])); }
                ss += __shfl_xor(ss, 16); ss += __shfl_xor(ss, 32);
                if (fq == 0) (void)__hip_atomic_fetch_add(ssq4 + row, ss, __ATOMIC_RELAXED, __HIP_MEMORY_SCOPE_AGENT);
            }
        asm volatile("s_waitcnt vmcnt(0)" ::: "memory");
        unsigned* c = cnt + 64 * u.pm;
        if ((threadIdx.x & 63) == 0) (void)__hip_atomic_fetch_add(c, 1u, __ATOMIC_RELAXED, __HIP_MEMORY_SCOPE_AGENT);
        { unsigned sp = 0;
            while ((unsigned)__builtin_amdgcn_readfirstlane(__hip_atomic_load(c, __ATOMIC_RELAXED, __HIP_MEMORY_SCOPE_AGENT)) < 32u) { __builtin_amdgcn_s_sleep(8); if (++sp > (1u << 17)) break; } }
        f32x4 g[2][2];
#pragma unroll
        for (int bj = 0; bj < 2; ++bj) { g[bj][0] = *(const f32x4*)(gf + col0 + HALF * bj); g[bj][1] = *(const f32x4*)(gf + col0 + HALF * bj + 4); }
#pragma unroll
        for (int ai = 0; ai < 2; ++ai)
#pragma unroll
            for (int m = 0; m < 4; ++m) {
                const int row = row0 + ai * HALF + m * 16;
                const float r4 = __builtin_amdgcn_rsqf(__hip_atomic_load(ssq4 + row, __ATOMIC_RELAXED, __HIP_MEMORY_SCOPE_AGENT) * (1.0f / D) + EPS);
#pragma unroll
                for (int bj = 0; bj < 2; ++bj) { float* op = out + (size_t)row * D + col0 + HALF * bj;
                    *(f32x4*)op = x[ai][m][bj][0] * r4 * g[bj][0]; *(f32x4*)(op + 4) = x[ai][m][bj][1] * r4 * g[bj][1]; }
            }
    }
};
}

#define XB_TMO      128
#define XB_XCNT(j)  (256  + 64 * (j))
#define XB_XSUB(j)  (1280 + 64 * (j))
#define XB_XGEN(j)  (2304 + 64 * (j))
#define XB_TOP      3328
#define XB_TOPGEN   3392
#define XCD_BAR_WORDS 3456
#define XB_SPIN_CAP (1u << 18)
__device__ __forceinline__ unsigned xb_ld(unsigned* p)              { return __hip_atomic_load(p, __ATOMIC_RELAXED, __HIP_MEMORY_SCOPE_AGENT); }
__device__ __forceinline__ unsigned xb_add(unsigned* p, unsigned v) { return __hip_atomic_fetch_add(p, v, __ATOMIC_RELAXED, __HIP_MEMORY_SCOPE_AGENT); }
__device__ __forceinline__ unsigned xb_xcc_id() { return (unsigned)__builtin_amdgcn_s_getreg((3 << 11) | 20) & 0xFu; }
#define XB_SPIN(cond, bar) do { unsigned _sp = 0; while (cond) { __builtin_amdgcn_s_sleep(1); \
    if ((++_sp & 255u) == 0u) { if (xb_ld(&(bar)[XB_TMO])) break; if (_sp > XB_SPIN_CAP) { atomicAdd(&(bar)[XB_TMO], 1u); break; } } } } while (0)
struct XcdBarrier { unsigned* bar; unsigned x; volatile LAS unsigned* st; };
__device__ __forceinline__ XcdBarrier xcd_barrier_post(unsigned* bar, volatile LAS unsigned* st) {
    XcdBarrier b; b.bar = bar; b.x = xb_xcc_id(); b.st = st;
    if (threadIdx.x == 0) (void)xb_add(&bar[XB_XCNT(b.x)], 1u);
    return b;
}
__device__ __forceinline__ void xcd_barrier_complete(unsigned* bar, unsigned x, unsigned& nloc, unsigned& nx) {
    const unsigned G = gridDim.x * gridDim.y * gridDim.z;
    unsigned sum, cnt, mine, sp = 0u;
    for (;;) {
        sum = 0u; cnt = 0u; mine = 0u;
#pragma unroll
        for (unsigned j = 0; j < 16; ++j) { const unsigned c = xb_ld(&bar[XB_XCNT(j)]); sum += c; cnt += (c > 0u) ? 1u : 0u; mine = (j == x) ? c : mine; }
        if (sum == G) break;
        __builtin_amdgcn_s_sleep(1);
        if ((++sp & 255u) == 0u) { if (xb_ld(&bar[XB_TMO])) break; if (sp > XB_SPIN_CAP) { atomicAdd(&bar[XB_TMO], 1u); break; } }
    }
    nloc = mine > 0u ? mine : 1u; nx = cnt > 0u ? cnt : 1u;
}
__device__ __forceinline__ void xcd_barrier(const XcdBarrier& b) {
    asm volatile("s_waitcnt vmcnt(0)" ::: "memory");
    __syncthreads();
    if (threadIdx.x == 0) {
        unsigned* bar = b.bar;
        __builtin_amdgcn_s_waitcnt(0);
        unsigned nloc = b.st[0], nx = b.st[1];
        if (nloc == 0u) { xcd_barrier_complete(bar, b.x, nloc, nx); b.st[0] = nloc; b.st[1] = nx; }
        const unsigned old = xb_add(&bar[XB_XSUB(b.x)], 1u);
        const unsigned gen = old / nloc;
        if (old + 1u == (gen + 1u) * nloc) {
            __builtin_amdgcn_fence(__ATOMIC_RELEASE, "agent");
            asm volatile("s_waitcnt vmcnt(0)" ::: "memory");
            const unsigned og = xb_add(&bar[XB_TOP], 1u);
            const unsigned tg = og / nx;
            if (og + 1u == (tg + 1u) * nx) xb_add(&bar[XB_TOPGEN], 1u);
            else XB_SPIN(xb_ld(&bar[XB_TOPGEN]) == tg, bar);
            __builtin_amdgcn_fence(__ATOMIC_ACQUIRE, "agent");
            xb_add(&bar[XB_XGEN(b.x)], 1u);
            asm volatile("s_waitcnt vmcnt(0)" ::: "memory");
        } else {
            XB_SPIN(xb_ld(&bar[XB_XGEN(b.x)]) == gen, bar);
            __builtin_amdgcn_fence(__ATOMIC_ACQUIRE, "agent");
            asm volatile("s_waitcnt vmcnt(0)" ::: "memory");
        }
    }
    __syncthreads();
}

constexpr int NWAVES = 8, NTHR = 512;
constexpr int LDS_BYTES = 147456;
struct Args { const float* in[22]; float* out; unsigned char* ws; int ph_lo, ph_hi; };
using pg8::cvt_pk_bf16; using pg8::bf_lo; using pg8::bf_hi;

__device__ __forceinline__ float wave_sum(float v) {
#pragma unroll
    for (int o = 1; o < 64; o <<= 1) v += __shfl_xor(v, o);
    return v;
}
__device__ __forceinline__ void tr_item(const float* W, int K, int N, bf16_t* WT, int prow0, const float* gk, LAS float* scr, int k0, int n0, int lane) {
    float tv[32];
#pragma unroll
    for (int i = 0; i < 32; ++i) { const int kk = 2 * i + (lane >> 5); tv[i] = W[(size_t)(k0 + kk) * N + n0 + (lane & 31)]; }
    const float gsc = gk ? gk[k0 + lane] : 1.0f;
#pragma unroll
    for (int i = 0; i < 32; ++i) { const int kk = 2 * i + (lane >> 5); scr[kk * 33 + (lane & 31)] = tv[i] * __shfl(gsc, kk); }
    asm volatile("s_waitcnt lgkmcnt(0)" ::: "memory");
    const int c = lane & 7;
#pragma unroll
    for (int j = 0; j < 4; ++j) { const int n = (lane >> 3) + 8 * j; const LAS float* s = scr + (8 * c) * 33 + n;
        u32x4 o; o.x = cvt_pk_bf16(s[0 * 33], s[1 * 33]); o.y = cvt_pk_bf16(s[2 * 33], s[3 * 33]); o.z = cvt_pk_bf16(s[4 * 33], s[5 * 33]); o.w = cvt_pk_bf16(s[6 * 33], s[7 * 33]);
        *(u32x4*)(WT + (size_t)(prow0 + n) * K + k0 + 8 * c) = o; }
    asm volatile("s_waitcnt lgkmcnt(0)" ::: "memory");
}

__device__ __forceinline__ void p0_prologue(const Args& a, LAS unsigned char* lds, int wave, int lane) {
    unsigned char* ws = a.ws;
    LAS float* scr = (LAS float*)(lds + wave * 16384);
    const int gw = blockIdx.x * NWAVES + wave, NGW = gridDim.x * NWAVES;
    constexpr int I_IN = 16 * 112, I_UP = 16 * 176, I_DN = 44 * 32, I_O = 16 * 32, I_PG = 16 * 32, I_PE = 4 * 32, I_GP = 8 * 32, I_POOL = 4 * 16;
    constexpr int NITEMS = I_IN + I_UP + I_DN + I_O + I_PG + I_PE + I_GP + I_POOL;
    for (int it = gw; it < NITEMS; it += NGW) {
        int r = it;
        if (r < I_IN) { const int kb = r / 112, nb = r % 112, n0 = 32 * nb; int p = n0;
            if (n0 >= 1024 && n0 < 1536) { const int l = n0 - 1024, tv = l >> 8, w = l & 255, wc = w >> 6, bj = (w >> 5) & 1; p = 1024 + 256 * tv + 128 * bj + 32 * wc; }
            tr_item(a.in[5], D, DIN, (bf16_t*)(ws + WS_WIN), p, a.in[4], scr, 64 * kb, n0, lane); continue; } r -= I_IN;
        if (r < I_UP) { const int kb = r / 176, nb = r % 176, n0 = 32 * nb; int p;
            if (n0 < DFF) p = 256 * (n0 >> 7) + (n0 & 127); else { const int l = n0 - DFF; p = 256 * (l >> 7) + 128 + (l & 127); }
            tr_item(a.in[14], D, NUP, (bf16_t*)(ws + WS_WUP), p, a.in[13], scr, 64 * kb, n0, lane); continue; } r -= I_UP;
        if (r < I_DN) { const int kb = r / 32, nb = r % 32; tr_item(a.in[17], DFF, D, (bf16_t*)(ws + WS_WDN), 32 * nb, nullptr, scr, 64 * kb, 32 * nb, lane); continue; } r -= I_DN;
        if (r < I_O) { const int kb = r / 32, nb = r % 32; tr_item(a.in[12], D, D, (bf16_t*)(ws + WS_WO), 32 * nb, nullptr, scr, 64 * kb, 32 * nb, lane); continue; } r -= I_O;
        if (r < I_PG) { const int kb = r / 32, nb = r % 32; tr_item(a.in[20], D, D, (bf16_t*)(ws + WS_WPG), 32 * nb, a.in[18], scr, 64 * kb, 32 * nb, lane); continue; } r -= I_PG;
        if (r < I_PE) { const int kb = r / 32, nb = r % 32; tr_item(a.in[19], PLE, D, (bf16_t*)(ws + WS_WPE), 32 * nb, nullptr, scr, 64 * kb, 32 * nb, lane); continue; } r -= I_PE;
        if (r < I_GP) { const int kb = r / 32, nb = r % 32; tr_item(a.in[11], 512, D, (bf16_t*)(ws + WS_WGP), 32 * nb, nullptr, scr, 64 * kb, 32 * nb, lane); continue; } r -= I_GP;
        { const int g = r >> 4, rr = r & 15, kb = rr >> 3, nb = rr & 7;
          tr_item(a.in[6] + (size_t)g * 128 * 256, 128, 256, (bf16_t*)(ws + WS_POOLT) + (size_t)g * 256 * 128, 32 * nb, nullptr, scr, 64 * kb, 32 * nb, lane); }
    }
    if (gw == 0) for (int i = lane; i < 320; i += 64) ((unsigned*)(ws + WS_CNT))[64 * i] = 0u;
    for (int it = gw; it < 512; it += NGW) { const f32x4 v = *(const f32x4*)(a.in[9] + (size_t)it * 256 + lane * 4);
        u32x2 w; w.x = cvt_pk_bf16(v[0], v[1]); w.y = cvt_pk_bf16(v[2], v[3]); *(u32x2*)((bf16_t*)(ws + WS_SGUW) + (size_t)it * 256 + lane * 4) = w; }
    float* r1 = (float*)(ws + WS_R1); float* s2 = (float*)(ws + WS_SSQ2); float* s3 = (float*)(ws + WS_SSQ3); float* s4 = (float*)(ws + WS_SSQ4);
    bf16_t* XB = (bf16_t*)(ws + WS_XB); bf16_t* PB = (bf16_t*)(ws + WS_PB);
    for (int m0 = gw; m0 < T; m0 += 2 * NGW) {
        const int m1 = m0 + NGW; const bool two = m1 < T; const int mm1 = two ? m1 : m0;
        const float* xr0 = m0 < TP ? a.in[0] + (size_t)m0 * D : a.in[1] + (size_t)(m0 - TP) * D;
        const float* pr0 = m0 < TP ? a.in[2] + (size_t)m0 * PLE : a.in[3] + (size_t)(m0 - TP) * PLE;
        const float* xr1 = mm1 < TP ? a.in[0] + (size_t)mm1 * D : a.in[1] + (size_t)(mm1 - TP) * D;
        const float* pr1 = mm1 < TP ? a.in[2] + (size_t)mm1 * PLE : a.in[3] + (size_t)(mm1 - TP) * PLE;
        f32x4 v0[4], v1[4];
#pragma unroll
        for (int j = 0; j < 4; ++j) { v0[j] = *(const f32x4*)(xr0 + 256 * j + 4 * lane); v1[j] = *(const f32x4*)(xr1 + 256 * j + 4 * lane); }
        const f32x4 pv0 = *(const f32x4*)(pr0 + 4 * lane), pv1 = *(const f32x4*)(pr1 + 4 * lane);
        float s0 = 0.f, s1 = 0.f;
#pragma unroll
        for (int j = 0; j < 4; ++j) { const f32x4 q0 = v0[j] * v0[j], q1 = v1[j] * v1[j]; s0 += (q0[0] + q0[1]) + (q0[2] + q0[3]); s1 += (q1[0] + q1[1]) + (q1[2] + q1[3]); }
        s0 = wave_sum(s0); s1 = wave_sum(s1);
#pragma unroll
        for (int j = 0; j < 4; ++j) { u32x2 w; w.x = cvt_pk_bf16(v0[j][0], v0[j][1]); w.y = cvt_pk_bf16(v0[j][2], v0[j][3]); *(u32x2*)(XB + (size_t)m0 * D + 256 * j + 4 * lane) = w; }
        { u32x2 w; w.x = cvt_pk_bf16(pv0[0], pv0[1]); w.y = cvt_pk_bf16(pv0[2], pv0[3]); *(u32x2*)(PB + (size_t)m0 * PLE + 4 * lane) = w; }
        if (lane == 0) { r1[m0] = __builtin_amdgcn_rsqf(s0 * (1.0f / D) + EPS); s2[m0] = 0.f; s3[m0] = 0.f; s4[m0] = 0.f; }
        if (two) {
#pragma unroll
            for (int j = 0; j < 4; ++j) { u32x2 w; w.x = cvt_pk_bf16(v1[j][0], v1[j][1]); w.y = cvt_pk_bf16(v1[j][2], v1[j][3]); *(u32x2*)(XB + (size_t)m1 * D + 256 * j + 4 * lane) = w; }
            { u32x2 w; w.x = cvt_pk_bf16(pv1[0], pv1[1]); w.y = cvt_pk_bf16(pv1[2], pv1[3]); *(u32x2*)(PB + (size_t)m1 * PLE + 4 * lane) = w; }
            if (lane == 0) { r1[m1] = __builtin_amdgcn_rsqf(s1 * (1.0f / D) + EPS); s2[m1] = 0.f; s3[m1] = 0.f; s4[m1] = 0.f; }
        }
    }
}

struct P2Stage { u32x4 z[5]; u32x4 v[2][2]; };
__device__ __forceinline__ void p2_fetch(P2Stage& st, const bf16_t* PROJ, int uid, int tid, int wave, int lane) {
    const int chunk = uid >> 2, q = uid & 3, t0 = chunk * 128;
    const int seqmask = t0 < TP ? 4095 : 8191;
    const bool at_start = (t0 & seqmask) == 0, at_end = ((t0 + 128) & seqmask) == 0;
#pragma unroll
    for (int k = 0; k < 5; ++k) { const int p = tid + NTHR * k; const int r = p >> 4, o = p & 15; const int t = t0 - 8 + r;
        const bool ok = (p < 144 * 16) && !((r < 8 && at_start) || (r >= 136 && at_end));
        st.z[k] = (u32x4){0u, 0u, 0u, 0u}; if (ok) st.z[k] = *(const u32x4*)(PROJ + (size_t)t * DIN + 128 * q + 8 * o); }
#pragma unroll
    for (int h2 = 0; h2 < 2; ++h2) { const bf16_t* src = PROJ + (size_t)(t0 + 2 * lane) * DIN + 1024 + 64 * (2 * q + h2) + 8 * wave;
        st.v[h2][0] = *(const u32x4*)src; st.v[h2][1] = *(const u32x4*)(src + DIN); }
}
__device__ __forceinline__ void p2_mixers(const Args& a, LAS unsigned char* lds, int tid, int wave, int lane) {
    unsigned char* ws = a.ws;
    const bf16_t* PROJ = (const bf16_t*)(ws + WS_PROJ); bf16_t* AG = (bf16_t*)(ws + WS_MG); bf16_t* GATED = (bf16_t*)a.out;
    const bf16_t* POOLT = (const bf16_t*)(ws + WS_POOLT); const bf16_t* SGUW = (const bf16_t*)(ws + WS_SGUW);
    const float* pool_scale = a.in[7]; const float* sgu_b = a.in[10];
    LAS unsigned char* zt = lds; LAS unsigned char* dt = lds + 36864; LAS unsigned char* vt = lds + 36864 + 34816;
    const int fr = lane & 15, fq = lane >> 4;
    P2Stage st;
    if ((int)blockIdx.x < 2560) p2_fetch(st, PROJ, blockIdx.x, tid, wave, lane);
    for (int uid = blockIdx.x; uid < 2560; uid += gridDim.x) {
        const int chunk = uid >> 2, q = uid & 3, t0 = chunk * 128;
        const int seqmask = t0 < TP ? 4095 : 8191;
        const bool at_start = (t0 & seqmask) == 0, at_end = ((t0 + 128) & seqmask) == 0;
#pragma unroll
        for (int k = 0; k < 5; ++k) { const int p = tid + NTHR * k; if (p < 144 * 16) *(LAS u32x4*)(zt + (p >> 4) * 256 + (p & 15) * 16) = st.z[k]; }
#pragma unroll
        for (int h2 = 0; h2 < 2; ++h2) { const u32x4 v0 = st.v[h2][0], v1 = st.v[h2][1];
            LAS unsigned char* dst = vt + (h2 * 64 + 8 * wave) * 272 + 4 * lane;
            *(LAS unsigned*)(dst + 0 * 272) = (v0.x & 0xffffu) | (v1.x << 16); *(LAS unsigned*)(dst + 1 * 272) = (v0.x >> 16) | (v1.x & 0xffff0000u);
            *(LAS unsigned*)(dst + 2 * 272) = (v0.y & 0xffffu) | (v1.y << 16); *(LAS unsigned*)(dst + 3 * 272) = (v0.y >> 16) | (v1.y & 0xffff0000u);
            *(LAS unsigned*)(dst + 4 * 272) = (v0.z & 0xffffu) | (v1.z << 16); *(LAS unsigned*)(dst + 5 * 272) = (v0.z >> 16) | (v1.z & 0xffff0000u);
            *(LAS unsigned*)(dst + 6 * 272) = (v0.w & 0xffffu) | (v1.w << 16); *(LAS unsigned*)(dst + 7 * 272) = (v0.w >> 16) | (v1.w & 0xffff0000u); }
        bf16x8 wf[2][4], sf[2][4];
        const int h2w = wave >> 2, ts = 32 * (wave & 3), hh = 2 * q + h2w;
#pragma unroll
        for (int nb = 0; nb < 2; ++nb)
#pragma unroll
            for (int ks = 0; ks < 4; ++ks) { const int row = 32 * wave + 8 * (fr >> 2) + 4 * nb + (fr & 3);
                wf[nb][ks] = *(const bf16x8*)(POOLT + ((size_t)(q * 256 + row)) * 128 + 32 * ks + 8 * fq); }
        const int col = 256 * q + 32 * wave + 8 * fq;
        u32x4 gg[8], uu[2][2]; float bb[2];
#pragma unroll
        for (int mb = 0; mb < 8; ++mb) gg[mb] = *(const u32x4*)(PROJ + (size_t)(t0 + 16 * mb + fr) * DIN + 1536 + col);
        __syncthreads();
        { const int half = 1 << q, tau0 = 16 * wave; const LAS unsigned* zd = (const LAS unsigned*)zt; LAS unsigned* dd = (LAS unsigned*)dt;
            float s0 = 0.f, s1 = 0.f;
            for (int r = tau0 + 8 - half; r < tau0 + 8 + half; ++r) { const unsigned w = zd[r * 64 + lane]; s0 += bf_lo(w); s1 += bf_hi(w); }
#pragma unroll 4
            for (int k = 0; k < 16; ++k) { const int tau = tau0 + k;
                int cnt = 2 * half; if (at_start) { const int o = half - tau; cnt -= o > 0 ? o : 0; } if (at_end) { const int o = tau + half - 128; cnt -= o > 0 ? o : 0; }
                const float inv = 1.0f / (float)cnt;
                const unsigned wcn = zd[(tau + 8) * 64 + lane];
                dd[tau * 68 + lane] = cvt_pk_bf16(s0 * inv - bf_lo(wcn), s1 * inv - bf_hi(wcn));
                const unsigned wl = zd[(tau + 8 - half) * 64 + lane], wh = zd[(tau + 8 + half) * 64 + lane];
                s0 += bf_lo(wh) - bf_lo(wl); s1 += bf_hi(wh) - bf_hi(wl); }
        }
        __syncthreads();
        if (uid + (int)gridDim.x < 2560) p2_fetch(st, PROJ, uid + gridDim.x, tid, wave, lane);
        { f32x4 acc[8][2];
#pragma unroll
            for (int mb = 0; mb < 8; ++mb) { acc[mb][0] = (f32x4){0.f, 0.f, 0.f, 0.f}; acc[mb][1] = (f32x4){0.f, 0.f, 0.f, 0.f}; }
#pragma unroll
            for (int mb = 0; mb < 8; ++mb)
#pragma unroll
                for (int ks = 0; ks < 4; ++ks) { const bf16x8 df = *(const LAS bf16x8*)(dt + (16 * mb + fr) * 272 + (32 * ks + 8 * fq) * 2);
                    acc[mb][0] = __builtin_amdgcn_mfma_f32_16x16x32_bf16(wf[0][ks], df, acc[mb][0], 0, 0, 0);
                    acc[mb][1] = __builtin_amdgcn_mfma_f32_16x16x32_bf16(wf[1][ks], df, acc[mb][1], 0, 0, 0); }
#pragma unroll
            for (int mb = 0; mb < 2; ++mb)
#pragma unroll
                for (int ks = 0; ks < 4; ++ks) sf[mb][ks] = *(const bf16x8*)(SGUW + ((size_t)hh * 128 + ts + 16 * mb + fr) * 128 + 32 * ks + 8 * fq);
#pragma unroll
            for (int mb = 0; mb < 2; ++mb) { const int tau = ts + 16 * mb + fr; bb[mb] = sgu_b[hh * 128 + tau];
#pragma unroll
                for (int hf = 0; hf < 2; ++hf) uu[mb][hf] = *(const u32x4*)(PROJ + (size_t)(t0 + tau) * DIN + 512 + 64 * hh + 32 * hf + 8 * fq); }
            const f32x4 sc0 = *(const f32x4*)(pool_scale + col), sc1 = *(const f32x4*)(pool_scale + col + 4);
#pragma unroll
            for (int mb = 0; mb < 8; ++mb) { const size_t t = (size_t)(t0 + 16 * mb + fr);
                const u32x4 g = gg[mb];
                const f32x4 x0 = acc[mb][0] * sc0, x1 = acc[mb][1] * sc1;
                u32x4 w; w.x = cvt_pk_bf16(x0[0] * bf_lo(g.x), x0[1] * bf_hi(g.x)); w.y = cvt_pk_bf16(x0[2] * bf_lo(g.y), x0[3] * bf_hi(g.y));
                w.z = cvt_pk_bf16(x1[0] * bf_lo(g.z), x1[1] * bf_hi(g.z)); w.w = cvt_pk_bf16(x1[2] * bf_lo(g.w), x1[3] * bf_hi(g.w));
                *(u32x4*)(AG + t * D + col) = w; }
        }
        { f32x4 acc[2][4];
#pragma unroll
            for (int mb = 0; mb < 2; ++mb)
#pragma unroll
                for (int nb = 0; nb < 4; ++nb) acc[mb][nb] = (f32x4){0.f, 0.f, 0.f, 0.f};
#pragma unroll
            for (int nb = 0; nb < 4; ++nb)
#pragma unroll
                for (int ks = 0; ks < 4; ++ks) { const int crow = 32 * (nb >> 1) + 8 * (fr >> 2) + 4 * (nb & 1) + (fr & 3);
                    const bf16x8 vf = *(const LAS bf16x8*)(vt + (h2w * 64 + crow) * 272 + (32 * ks + 8 * fq) * 2);
                    acc[0][nb] = __builtin_amdgcn_mfma_f32_16x16x32_bf16(vf, sf[0][ks], acc[0][nb], 0, 0, 0);
                    acc[1][nb] = __builtin_amdgcn_mfma_f32_16x16x32_bf16(vf, sf[1][ks], acc[1][nb], 0, 0, 0); }
#pragma unroll
            for (int mb = 0; mb < 2; ++mb) { const int tau = ts + 16 * mb + fr; const size_t t = (size_t)(t0 + tau); const float b = bb[mb];
#pragma unroll
                for (int hf = 0; hf < 2; ++hf) { const int cb_ = 64 * hh + 32 * hf + 8 * fq;
                    const u32x4 u_ = uu[mb][hf];
                    const f32x4 x0 = acc[mb][2 * hf] + b, x1 = acc[mb][2 * hf + 1] + b;
                    u32x4 w; w.x = cvt_pk_bf16(x0[0] * bf_lo(u_.x), x0[1] * bf_hi(u_.x)); w.y = cvt_pk_bf16(x0[2] * bf_lo(u_.y), x0[3] * bf_hi(u_.y));
                    w.z = cvt_pk_bf16(x1[0] * bf_lo(u_.z), x1[1] * bf_hi(u_.z)); w.w = cvt_pk_bf16(x1[2] * bf_lo(u_.w), x1[3] * bf_hi(u_.w));
                    *(u32x4*)(GATED + t * 512 + cb_) = w; } }
        }
        __syncthreads();
    }
}

__global__ void __launch_bounds__(NTHR, 2) fwd_mega(Args a) {
    extern __shared__ __attribute__((aligned(16))) unsigned char lds_raw[];
    LAS unsigned char* lds = (LAS unsigned char*)lds_raw;
    cg::grid_group grid = cg::this_grid();
    const int tid = threadIdx.x, lane = tid & 63, wave = __builtin_amdgcn_readfirstlane(tid >> 6);
    const int G = gridDim.x, bx = blockIdx.x;
    unsigned char* ws = a.ws;
    const int lo = a.ph_lo, hi = a.ph_hi;
    volatile LAS unsigned* MISC = (volatile LAS unsigned*)(lds + 131072 + 1024);
    unsigned* barw = (unsigned*)(ws + WS_BAR);
    if (tid < 4) MISC[tid] = 0u;
    __syncthreads();
    XcdBarrier xbar = xcd_barrier_post(barw, MISC);
    if (lo < 0) grid.sync();
#define IN(k) (lo <= (k) && (k) < hi)
#define SEAM(k) do { if (IN(k) && IN((k) + 1)) xcd_barrier(xbar); } while (0)
    if (IN(0)) { p0_prologue(a, lds, wave, lane); } SEAM(0);
    if (IN(1)) { pg8::Gemm g{(const bf16_t*)(ws + WS_XB), (const bf16_t*)(ws + WS_WIN), D, 0}; pg8::StaticOrder S; S.init(T / 256, DIN / 256, G, bx);
        pg8::EpiProj E{(bf16_t*)(ws + WS_PROJ), (const float*)(ws + WS_R1), a.in[8]};
        pg8::gemm_phase<pg8::EpiProj, pg8::StaticOrder, true, true>(lds, g, S, E); } SEAM(1);
    if (IN(2)) { p2_mixers(a, lds, tid, wave, lane); } SEAM(2);
    if (IN(3)) { pg8::Gemm g{(const bf16_t*)a.out, (const bf16_t*)(ws + WS_WGP), 512, 0}; pg8::StaticOrder S; S.init(T / 256, D / 256, G, bx);
        pg8::EpiMerge E{(bf16_t*)(ws + WS_MG), (const bf16_t*)(ws + WS_PROJ)};
        pg8::gemm_phase<pg8::EpiMerge, pg8::StaticOrder, true, true>(lds, g, S, E); } SEAM(3);
    if (IN(4)) { pg8::Gemm g{(const bf16_t*)(ws + WS_MG), (const bf16_t*)(ws + WS_WO), D, 0}; pg8::StaticOrder S; S.init(T / 256, D / 256, G, bx);
        pg8::EpiRes E{(bf16_t*)(ws + WS_XB), (float*)(ws + WS_SSQ2)};
        pg8::gemm_phase<pg8::EpiRes, pg8::StaticOrder, true, true>(lds, g, S, E); } SEAM(4);
    if (IN(5)) { pg8::Gemm g{(const bf16_t*)(ws + WS_XB), (const bf16_t*)(ws + WS_WUP), D, 1}; pg8::StaticOrder S; S.init(325, NUP / 256, G, bx);
        pg8::EpiUp E{(bf16_t*)(ws + WS_PROJ), (const float*)(ws + WS_SSQ2), a.in[15], a.in[16]};
        pg8::gemm_phase<pg8::EpiUp, pg8::StaticOrder, true, true>(lds, g, S, E);
        pg8::Gemm g2{(const bf16_t*)(ws + WS_PB), (const bf16_t*)(ws + WS_WPE), PLE, 0}; pg8::StaticOrder S2; S2.init(T / 256, D / 256, G, bx);
        pg8::EpiBf E2{(bf16_t*)(ws + WS_MG)};
        pg8::gemm_phase<pg8::EpiBf, pg8::StaticOrder, true, true>(lds, g2, S2, E2); } SEAM(5);
    if (IN(6)) { pg8::Gemm g{(const bf16_t*)(ws + WS_PROJ), (const bf16_t*)(ws + WS_WDN), DFF, 0}; pg8::StaticOrder S; S.init(T / 256, D / 256, G, bx);
        pg8::EpiRes E{(bf16_t*)(ws + WS_XB), (float*)(ws + WS_SSQ3)};
        pg8::gemm_phase<pg8::EpiRes, pg8::StaticOrder, true, true>(lds, g, S, E); } SEAM(6);
    if (IN(7)) { pg8::Gemm g{(const bf16_t*)(ws + WS_XB), (const bf16_t*)(ws + WS_WPG), D, 0}; pg8::StaticOrder S; S.init(T / 256, D / 256, G, bx);
        pg8::EpiPg E{(const bf16_t*)(ws + WS_XB), (const bf16_t*)(ws + WS_MG), a.out, (const float*)(ws + WS_SSQ3), (float*)(ws + WS_SSQ4), (unsigned*)(ws + WS_CNT), a.in[21]};
        pg8::gemm_phase<pg8::EpiPg, pg8::StaticOrder, true, true>(lds, g, S, E); }
#undef IN
#undef SEAM
}

#ifndef MK_N_LAUNCHES
#define MK_N_LAUNCHES 1
#endif
extern "C" void kernel_launch(void* const* d_in, const int* in_sizes, int n_in, void* d_out, int out_size, void* d_ws, size_t ws_size, hipStream_t stream) {
    static int grid = 0;
    if (grid == 0) {
        if (n_in != 22 || out_size != T * D || ws_size < WS_END) { fprintf(stderr, "kernel_launch: unexpected shapes: n_in %d out %d ws %zu\n", n_in, out_size, ws_size); grid = -1; return; }
        int dev = 0, cus = 0, per_cu = 0;
        (void)hipGetDevice(&dev); (void)hipDeviceGetAttribute(&cus, hipDeviceAttributeMultiprocessorCount, dev);
        if (hipFuncSetAttribute((const void*)fwd_mega, hipFuncAttributeMaxDynamicSharedMemorySize, LDS_BYTES) != hipSuccess) { fprintf(stderr, "kernel_launch: hipFuncSetAttribute failed\n"); grid = -1; return; }
        if (hipOccupancyMaxActiveBlocksPerMultiprocessor(&per_cu, (const void*)fwd_mega, NTHR, LDS_BYTES) != hipSuccess || per_cu < 1) { fprintf(stderr, "kernel_launch: occupancy query says %d\n", per_cu); per_cu = 1; }
        (void)hipGetLastError();
        grid = cus * 1;
        if (grid <= 0) grid = 256;
    }
    if (grid < 0) return;
    if (hipMemsetAsync((char*)d_ws + WS_BAR, 0, XCD_BAR_WORDS * 4, stream) != hipSuccess) { fprintf(stderr, "kernel_launch: memset of the barrier words failed\n"); return; }
    Args a{};
    for (int i = 0; i < 22; ++i) a.in[i] = (const float*)d_in[i];
    a.out = (float*)d_out; a.ws = (unsigned char*)d_ws;
#if MK_N_LAUNCHES == 1
    a.ph_lo = 0; a.ph_hi = NPH;
    void* args[] = {&a};
    hipError_t e = hipLaunchCooperativeKernel((const void*)fwd_mega, dim3(grid), dim3(NTHR), args, LDS_BYTES, stream);
    if (e != hipSuccess) fprintf(stderr, "kernel_launch: cooperative launch failed: %s (grid %d)\n", hipGetErrorString(e), grid);
#endif
#ifdef PROBE_PHASE
    a.ph_lo = PROBE_PHASE; a.ph_hi = PROBE_PHASE + 1; hipLaunchKernelGGL(fwd_mega, dim3(grid), dim3(NTHR), LDS_BYTES, stream, a);
#endif
}
```

```cpp
#include <hip/hip_runtime.h>
#include <hip/hip_cooperative_groups.h>
#include <cstdio>
#include <cstdint>
namespace cg = cooperative_groups;

#define LAS __attribute__((address_space(3)))
typedef unsigned short bf16_t;
typedef short bf16x8 __attribute__((ext_vector_type(8)));
typedef float f32x4 __attribute__((ext_vector_type(4)));
typedef float f32x2 __attribute__((ext_vector_type(2)));
typedef unsigned u32x4 __attribute__((ext_vector_type(4)));
typedef unsigned u32x2 __attribute__((ext_vector_type(2)));

constexpr int T = 81920, TP = 65536, D = 1024, DIN = 3584, DFF = 2816, NUP = 5632, PLE = 256;
constexpr float EPS = 1e-6f;
constexpr int NPH = 8;
constexpr size_t MiB = 1u << 20;
constexpr size_t WS_R1 = 0, WS_SSQ2 = WS_R1 + (size_t)T * 4, WS_SSQ3 = WS_SSQ2 + (size_t)T * 4, WS_SSQ4 = WS_SSQ3 + (size_t)T * 4;
constexpr size_t WS_CNT = WS_SSQ4 + (size_t)T * 4;
constexpr size_t WS_BAR = 1536 * 1024;
constexpr size_t WS_WIN = 2 * MiB;
constexpr size_t WS_WUP = WS_WIN + (size_t)DIN * D * 2;
constexpr size_t WS_WDN = WS_WUP + (size_t)NUP * D * 2;
constexpr size_t WS_WO = WS_WDN + (size_t)D * DFF * 2;
constexpr size_t WS_WPG = WS_WO + (size_t)D * D * 2;
constexpr size_t WS_WPE = WS_WPG + (size_t)D * D * 2;
constexpr size_t WS_WGP = WS_WPE + (size_t)D * PLE * 2;
constexpr size_t WS_POOLT = WS_WGP + (size_t)D * 512 * 2;
constexpr size_t WS_SGUW = WS_POOLT + (size_t)4 * 256 * 128 * 2;
constexpr size_t WS_PB = 32 * MiB;
constexpr size_t WS_XB = 73 * MiB;
constexpr size_t WS_MG = 234 * MiB;
constexpr size_t WS_PROJ = 394 * MiB;
constexpr size_t WS_END = 954 * MiB;
static_assert(WS_SGUW + 8 * 128 * 128 * 2 <= WS_PB && WS_CNT + 320 * 256 <= WS_BAR, "weights / control words fit");

namespace pg8 {
constexpr int BM = 256, BK = 64, HALF = 128, HTB = HALF * BK * 2, STAGE_BYTES = 8 * HTB, NXCD = 8, WGM = 8;
__host__ __device__ __forceinline__ int lds_byte(int r, int c) { const int st = (r >> 4) * 2 + (c >> 5), rr = r & 15, cc = c & 31, ob = rr * 64 + cc * 2; return st * 1024 + (ob ^ (((ob >> 9) & 1) << 5)); }
__host__ __device__ __forceinline__ void stage_rc(int b, int& R, int& C) { const int st = b / 1024, sb = b % 1024, swz = sb ^ (((sb >> 9) & 1) << 5); R = (st >> 1) * 16 + swz / 64; C = (st & 1) * 32 + (swz % 64) / 2; }
__host__ __device__ __forceinline__ int perm32(int rho) { const int n = rho >> 4, i = rho & 15; return 8 * (i >> 2) + 4 * n + (i & 3); }

struct Unit { int pm, pn; };
struct Gemm { const bf16_t* A; const bf16_t* Bt; int K; int seg; };
__host__ __device__ __forceinline__ int seg_bt(int s) { const int sg = s / 65, j = s - 65 * sg; return 8192 * sg + 126 * j; }

struct StaticOrder {
    int nM, nN, nwg, G, c;
    __host__ __device__ void init(int nM_, int nN_, int G_, int c_) { nM = nM_; nN = nN_; nwg = nM * nN; G = G_; c = c_; }
    __host__ __device__ bool next(int i, Unit& u) const {
        const long L = (long)i * G + c; if (L >= nwg) return false;
        int wgid = (int)L; { const int q = nwg / NXCD, r = nwg % NXCD, xcd = wgid % NXCD, off = wgid / NXCD; wgid = (xcd < r ? xcd * (q + 1) : r * (q + 1) + (xcd - r) * q) + off; }
        const int nig = WGM * nN, gid = wgid / nig, fm = gid * WGM, gsz = (nM - fm) < WGM ? (nM - fm) : WGM;
        u.pm = fm + ((wgid % nig) % gsz); u.pn = (wgid % nig) / gsz; return true;
    }
    __device__ __forceinline__ void a_ready(const Unit&) const {}
    __device__ __forceinline__ void done(const Unit&) const {}
};

__device__ __forceinline__ unsigned cvt_pk_bf16(float lo, float hi) { unsigned r; asm volatile("v_cvt_pk_bf16_f32 %0, %1, %2" : "=v"(r) : "v"(lo), "v"(hi)); return r; }
__device__ __forceinline__ f32x2 gelu_pk(f32x2 v) {
    f32x2 z = v * 0.70710678118f;
    z.x = __builtin_amdgcn_fmed3f(z.x, -3.832506856900711f, 3.832506856900711f); z.y = __builtin_amdgcn_fmed3f(z.y, -3.832506856900711f, 3.832506856900711f);
    const f32x2 z2 = z * z;
    f32x2 p = z2 * 0.00022905065861350646f + 0.0034082910107109506f; p = p * z2 + 0.050955695062380861f; p = p * z2 + 0.18520832239976145f; p = p * z2 + 1.128379143519084f;
    f32x2 q = z2 * -1.1791602954361697e-7f + 0.000023547966471313185f; q = q * z2 + 0.0010179625278914885f; q = q * z2 + 0.014070470171167667f; q = q * z2 + 0.11098505178285362f; q = q * z2 + 0.49746925110067538f; q = q * z2 + 1.0f;
    f32x2 r; r.x = __builtin_amdgcn_rcpf(q.x); r.y = __builtin_amdgcn_rcpf(q.y);
    const f32x2 e = (z * p) * r, hv = v * 0.5f;
    return hv * e + hv;
}
__device__ __forceinline__ f32x4 gelu4(f32x4 v) { const f32x2 a = gelu_pk((f32x2){v[0], v[1]}), b = gelu_pk((f32x2){v[2], v[3]}); return (f32x4){a.x, a.y, b.x, b.y}; }
__device__ __forceinline__ float sigm(float x) { return __builtin_amdgcn_rcpf(1.0f + __builtin_amdgcn_exp2f(x * -1.44269504089f)); }
__device__ __forceinline__ f32x4 sigm4(f32x4 v) { return (f32x4){sigm(v[0]), sigm(v[1]), sigm(v[2]), sigm(v[3])}; }
__device__ __forceinline__ float sigp(float y) { return __builtin_amdgcn_rcpf(1.0f + __builtin_amdgcn_exp2f(y)); }
__device__ __forceinline__ f32x4 sigp4(f32x4 v) { return (f32x4){sigp(v[0]), sigp(v[1]), sigp(v[2]), sigp(v[3])}; }
__device__ __forceinline__ float bf_lo(unsigned w) { return __uint_as_float(w << 16); }
__device__ __forceinline__ float bf_hi(unsigned w) { return __uint_as_float(w & 0xffff0000u); }

template <class Epi, class Sched, bool ALIGN_EPI = false, bool SP2 = false>
__device__ __forceinline__ void gemm_phase(LAS unsigned char* lds, const Gemm g, const Sched& S, const Epi& E) {
    const int tid = threadIdx.x, wid = __builtin_amdgcn_readfirstlane(tid >> 6), lane = tid & 63, wr = wid >> 2, wc = wid & 3, fr = lane & 15, fq = lane >> 4;
    const int K = g.K, nt = K / BK;
    unsigned voffA[2], voffB[2];
#pragma unroll
    for (int i = 0; i < 2; ++i) { int R, C; stage_rc(tid * 16 + i * 8192, R, C); const int Rb = Epi::PERM ? ((R & ~31) + perm32(R & 31)) : R;
        const int Ra = g.seg ? (8 * (R & 15) + ((R >> 4) & 3)) : (R & 63);
        voffA[i] = (unsigned)(Ra * K + C) * 2u; voffB[i] = (unsigned)(Rb * K + C) * 2u; }
    const size_t kstep = (size_t)(BK * 2);
    const size_t hstep = (size_t)HALF * K * 2;
    const size_t tstep = 2 * hstep;
    const size_t rowb = (size_t)K * 2;
    const size_t hstepA = (g.seg ? 4 : 128) * rowb;
#define PG8_ABASE(pm_) ((const char*)g.A + (size_t)(g.seg ? seg_bt(2 * (pm_)) : 256 * (pm_)) * rowb)
#define PG8_AGAP(pm_) ((size_t)(g.seg ? (seg_bt(2 * (pm_) + 1) - seg_bt(2 * (pm_))) : 64) * rowb)
    const unsigned ldsw = (unsigned)wid * 1024u;
    const int aoff = lds_byte(wr * 64 + fr, fq * 8), boff = lds_byte(wc * 32 + fr, fq * 8);
#define PG8_SA(b, h) (((b) * 2 + (h)) * HTB)
#define PG8_SB(b, h) ((4 + (b) * 2 + (h)) * HTB)
#define PG8_STAGE(bufoff, gbase, voff) do { _Pragma("unroll") for (int _i = 0; _i < 2; ++_i) \
        __builtin_amdgcn_global_load_lds((const unsigned*)((const char*)(gbase) + (voff)[_i]), (LAS unsigned*)(lds + (bufoff) + ldsw + _i * 8192), 16, 0, 0); } while (0)
#define PG8_STAGE_A(bufoff, gbase, gapb) do { _Pragma("unroll") for (int _i = 0; _i < 2; ++_i) \
        __builtin_amdgcn_global_load_lds((const unsigned*)((const char*)(gbase) + (size_t)_i * (gapb) + voffA[_i]), (LAS unsigned*)(lds + (bufoff) + ldsw + _i * 8192), 16, 0, 0); } while (0)
#define PG8_LDA(dst, b, h) do { _Pragma("unroll") for (int m = 0; m < 4; ++m) _Pragma("unroll") for (int k = 0; k < 2; ++k) dst[m][k] = *(const LAS bf16x8*)(lds + PG8_SA(b, h) + aoff + m * 2048 + k * 1024); } while (0)
#define PG8_LDB(dst, b, h) do { _Pragma("unroll") for (int n = 0; n < 2; ++n) _Pragma("unroll") for (int k = 0; k < 2; ++k) dst[n][k] = *(const LAS bf16x8*)(lds + PG8_SB(b, h) + boff + n * 2048 + k * 1024); } while (0)
#define PG8_MMA(ai, bj, At, Bt) do { __builtin_amdgcn_s_setprio(1); _Pragma("unroll") for (int m = 0; m < 4; ++m) _Pragma("unroll") for (int n = 0; n < 2; ++n) _Pragma("unroll") for (int k = 0; k < 2; ++k) \
        acc[ai][bj][m][n] = __builtin_amdgcn_mfma_f32_16x16x32_bf16(Bt[n][k], At[m][k], acc[ai][bj][m][n], 0, 0, 0); __builtin_amdgcn_s_setprio(0); } while (0)
#define PG8_WAIT_V(n) asm volatile("s_waitcnt vmcnt(" #n ")" ::: "memory")
#define PG8_WAIT_L(n) asm volatile("s_waitcnt lgkmcnt(" #n ")" ::: "memory")
#define PG8_BAR __builtin_amdgcn_s_barrier()
#define PG8_SCHED __builtin_amdgcn_sched_barrier(0)
    Unit cur, nxt; int ui = 0;
    if (!S.next(0, cur)) return;
    f32x4 acc[2][2][4][2];
#pragma unroll
    for (int a = 0; a < 2; ++a)
#pragma unroll
        for (int b = 0; b < 2; ++b)
#pragma unroll
            for (int m = 0; m < 4; ++m)
#pragma unroll
                for (int n = 0; n < 2; ++n) acc[a][b][m][n] = (f32x4){0.f, 0.f, 0.f, 0.f};
    bf16x8 At[4][2], B0[2][2], B1[2][2];
    const char* cA = PG8_ABASE(cur.pm); size_t cG = PG8_AGAP(cur.pm); const char* cB = (const char*)g.Bt + (size_t)cur.pn * tstep;
    S.a_ready(cur);
    if constexpr (SP2) {
        PG8_STAGE(PG8_SB(0, 0), cB, voffB); PG8_STAGE(PG8_SB(0, 1), cB + hstep, voffB); PG8_STAGE_A(PG8_SA(0, 0), cA, cG); PG8_STAGE_A(PG8_SA(0, 1), cA + hstepA, cG);
        if (wr == 1) PG8_BAR;
        PG8_WAIT_V(2); PG8_BAR;
        PG8_STAGE(PG8_SB(1, 0), cB + kstep, voffB); PG8_STAGE_A(PG8_SA(1, 0), cA + kstep, cG); PG8_STAGE(PG8_SB(1, 1), cB + hstep + kstep, voffB);
        PG8_WAIT_V(6); PG8_BAR;
    } else {
        PG8_STAGE(PG8_SB(0, 0), cB, voffB); PG8_STAGE_A(PG8_SA(0, 0), cA, cG); PG8_STAGE(PG8_SB(0, 1), cB + hstep, voffB); PG8_STAGE_A(PG8_SA(0, 1), cA + hstepA, cG);
        if (wr == 1) PG8_BAR;
        PG8_WAIT_V(4); PG8_BAR;
        PG8_STAGE(PG8_SB(1, 0), cB + kstep, voffB); PG8_STAGE_A(PG8_SA(1, 0), cA + kstep, cG); PG8_STAGE(PG8_SB(1, 1), cB + hstep + kstep, voffB);
        PG8_WAIT_V(6); PG8_BAR;
    }
    for (;;) {
        const bool has_next = S.next(ui + 1, nxt);
        const char* nA = has_next ? PG8_ABASE(nxt.pm) : cA; const size_t nG = has_next ? PG8_AGAP(nxt.pm) : cG; const char* nB = has_next ? (const char*)g.Bt + (size_t)nxt.pn * tstep : cB;
#pragma unroll 1
        for (int t = 0; t < nt; t += 2) {
            const bool last = (t == nt - 2);
            const char* a1 = cA + (size_t)(t + 1) * kstep;
            const char* a2 = last ? nA : cA + (size_t)(t + 2) * kstep; const char* b2 = last ? nB : cB + (size_t)(t + 2) * kstep;
            const char* a3 = a2 + kstep; const char* b3 = b2 + kstep; const size_t g2 = last ? nG : cG;
            if (last && has_next) S.a_ready(nxt);
            if constexpr (SP2) {
            PG8_LDB(B0, 0, 0); PG8_LDB(B1, 0, 1); PG8_SCHED; PG8_LDA(At, 0, 0); PG8_STAGE_A(PG8_SA(1, 1), a1 + hstepA, cG);
            PG8_WAIT_V(8); PG8_WAIT_L(0); PG8_BAR; PG8_MMA(0, 0, At, B0); PG8_MMA(0, 1, At, B1); PG8_BAR; PG8_SCHED;
            PG8_LDA(At, 0, 1); PG8_STAGE(PG8_SB(0, 0), b2, voffB); PG8_STAGE(PG8_SB(0, 1), b2 + hstep, voffB); PG8_STAGE_A(PG8_SA(0, 0), a2, g2);
            PG8_WAIT_V(8); PG8_WAIT_L(0); PG8_BAR; PG8_MMA(1, 0, At, B0); PG8_MMA(1, 1, At, B1); PG8_BAR; PG8_SCHED;
            PG8_LDB(B0, 1, 0); PG8_LDB(B1, 1, 1); PG8_SCHED; PG8_LDA(At, 1, 0); PG8_STAGE_A(PG8_SA(0, 1), a2 + hstepA, g2);
            PG8_WAIT_V(8); PG8_WAIT_L(0); PG8_BAR; PG8_MMA(0, 0, At, B0); PG8_MMA(0, 1, At, B1); PG8_BAR; PG8_SCHED;
            PG8_LDA(At, 1, 1); PG8_STAGE(PG8_SB(1, 0), b3, voffB); PG8_STAGE(PG8_SB(1, 1), b3 + hstep, voffB); PG8_STAGE_A(PG8_SA(1, 0), a3, g2);
            PG8_WAIT_V(8); PG8_WAIT_L(0); PG8_BAR; PG8_MMA(1, 0, At, B0); PG8_MMA(1, 1, At, B1); PG8_BAR; PG8_SCHED;
            } else {
            PG8_LDB(B0, 0, 0); PG8_SCHED; PG8_LDA(At, 0, 0); PG8_STAGE_A(PG8_SA(1, 1), a1 + hstepA, cG);
            PG8_WAIT_L(8); PG8_BAR; PG8_WAIT_L(0); PG8_MMA(0, 0, At, B0); PG8_BAR; PG8_SCHED;
            PG8_LDB(B1, 0, 1); PG8_STAGE(PG8_SB(0, 0), b2, voffB);
            PG8_BAR; PG8_WAIT_L(0); PG8_MMA(0, 1, At, B1); PG8_BAR;
            PG8_LDA(At, 0, 1); PG8_STAGE_A(PG8_SA(0, 0), a2, g2);
            PG8_BAR; PG8_WAIT_L(0); PG8_MMA(1, 0, At, B0); PG8_BAR; PG8_SCHED;
            PG8_STAGE(PG8_SB(0, 1), b2 + hstep, voffB);
            PG8_WAIT_V(6); PG8_BAR; PG8_MMA(1, 1, At, B1); PG8_BAR;
            PG8_LDB(B0, 1, 0); PG8_SCHED; PG8_LDA(At, 1, 0); PG8_STAGE_A(PG8_SA(0, 1), a2 + hstepA, g2);
            PG8_WAIT_L(8); PG8_BAR; PG8_WAIT_L(0); PG8_MMA(0, 0, At, B0); PG8_BAR; PG8_SCHED;
            PG8_LDB(B1, 1, 1); PG8_STAGE(PG8_SB(1, 0), b3, voffB);
            PG8_BAR; PG8_WAIT_L(0); PG8_MMA(0, 1, At, B1); PG8_BAR;
            PG8_LDA(At, 1, 1); PG8_STAGE_A(PG8_SA(1, 0), a3, g2);
            PG8_BAR; PG8_WAIT_L(0); PG8_MMA(1, 0, At, B0); PG8_BAR; PG8_SCHED;
            PG8_STAGE(PG8_SB(1, 1), b3 + hstep, voffB);
            PG8_WAIT_V(6); PG8_BAR; PG8_MMA(1, 1, At, B1); PG8_BAR;
            }
        }
        if constexpr (ALIGN_EPI) { if (wr == 0) PG8_BAR; }
        E(acc, cur, wr, wc, fr, fq); S.done(cur);
        if (!has_next) break;
#pragma unroll
        for (int a = 0; a < 2; ++a)
#pragma unroll
            for (int b = 0; b < 2; ++b)
#pragma unroll
                for (int m = 0; m < 4; ++m)
#pragma unroll
                    for (int n = 0; n < 2; ++n) acc[a][b][m][n] = (f32x4){0.f, 0.f, 0.f, 0.f};
        cur = nxt; cA = nA; cG = nG; cB = nB; ++ui;
        if constexpr (ALIGN_EPI) { if (wr == 1) PG8_BAR; }
    }
    PG8_WAIT_V(0);
    if constexpr (!ALIGN_EPI) { if (wr == 0) PG8_BAR; }
    PG8_BAR;
#undef PG8_SA
#undef PG8_STAGE_A
#undef PG8_ABASE
#undef PG8_AGAP
#undef PG8_SB
#undef PG8_STAGE
#undef PG8_LDA
#undef PG8_LDB
#undef PG8_MMA
#undef PG8_WAIT_V
#undef PG8_WAIT_L
#undef PG8_BAR
#undef PG8_SCHED
}


struct EpiProj {
    static constexpr bool PERM = true;
    bf16_t* O; const float* r1; const float* gv;
    __device__ __forceinline__ void operator()(const f32x4 (&acc)[2][2][4][2], const Unit& u, int wr, int wc, int fr, int fq) const {
        const int row0 = u.pm * BM + wr * 64 + fr, pn = u.pn;
        const int mode = pn < 4 ? 0 : (pn < 6 ? 2 : (pn < 10 ? 4 : 3));
        if (mode == 2) {
            const int h = 4 * (pn - 4) + wc;
            f32x4 g[2][2];
#pragma unroll
            for (int bj = 0; bj < 2; ++bj)
#pragma unroll
                for (int n = 0; n < 2; ++n) g[bj][n] = *(const f32x4*)(gv + h * 64 + 32 * bj + 8 * fq + 4 * n);
#pragma unroll
            for (int ai = 0; ai < 2; ++ai)
#pragma unroll
                for (int m = 0; m < 4; ++m) {
                    const int row = row0 + ai * HALF + m * 16; const float rs = r1[row];
                    f32x4 v[2][2]; float ss = 0.f;
#pragma unroll
                    for (int bj = 0; bj < 2; ++bj)
#pragma unroll
                        for (int n = 0; n < 2; ++n) { v[bj][n] = gelu4(acc[ai][bj][m][n] * rs); const f32x4 q = v[bj][n] * v[bj][n]; ss += (q[0] + q[1]) + (q[2] + q[3]); }
                    ss += __shfl_xor(ss, 16); ss += __shfl_xor(ss, 32);
                    const float ri = __builtin_amdgcn_rsqf(ss * (1.0f / 64.0f) + EPS);
                    bf16_t* rowp = O + (size_t)row * DIN + pn * BM + 64 * wc + 8 * fq;
#pragma unroll
                    for (int bj = 0; bj < 2; ++bj) { const f32x4 a = v[bj][0] * ri * g[bj][0], b = v[bj][1] * ri * g[bj][1];
                        u32x4 w; w.x = cvt_pk_bf16(a[0], a[1]); w.y = cvt_pk_bf16(a[2], a[3]); w.z = cvt_pk_bf16(b[0], b[1]); w.w = cvt_pk_bf16(b[2], b[3]);
                        *(u32x4*)(rowp + 32 * bj) = w; }
                }
        } else {
#pragma unroll
            for (int ai = 0; ai < 2; ++ai)
#pragma unroll
                for (int m = 0; m < 4; ++m) {
                    const int row = row0 + ai * HALF + m * 16; const float rs = r1[row];
                    bf16_t* rowp = O + (size_t)row * DIN + pn * BM + 32 * wc + 8 * fq;
                    const float rq = (mode >= 3) ? rs * -1.44269504089f : rs;
#pragma unroll
                    for (int bj = 0; bj < 2; ++bj) { f32x4 a = acc[ai][bj][m][0] * rq, b = acc[ai][bj][m][1] * rq;
                        if (mode == 1) { a = gelu4(a); b = gelu4(b); } else if (mode == 3) { a = sigp4(a); b = sigp4(b); }
                        u32x4 w; w.x = cvt_pk_bf16(a[0], a[1]); w.y = cvt_pk_bf16(a[2], a[3]); w.z = cvt_pk_bf16(b[0], b[1]); w.w = cvt_pk_bf16(b[2], b[3]);
                        *(u32x4*)(rowp + HALF * bj) = w; }
                }
        }
    }
};

struct EpiMerge {
    static constexpr bool PERM = true;
    bf16_t* AG; const bf16_t* PROJ;
    __device__ __forceinline__ void operator()(const f32x4 (&acc)[2][2][4][2], const Unit& u, int wr, int wc, int fr, int fq) const {
        const int row0 = u.pm * BM + wr * 64 + fr, col0 = u.pn * BM + 32 * wc + 8 * fq;
#pragma unroll
        for (int ai = 0; ai < 2; ++ai)
#pragma unroll
            for (int m = 0; m < 4; ++m) {
                const int row = row0 + ai * HALF + m * 16;
#pragma unroll
                for (int bj = 0; bj < 2; ++bj) {
                    bf16_t* ap = AG + (size_t)row * D + col0 + HALF * bj;
                    const u32x4 a = *(const u32x4*)ap, g = *(const u32x4*)(PROJ + (size_t)row * DIN + 2560 + col0 + HALF * bj);
                    const f32x4 c0 = acc[ai][bj][m][0], c1 = acc[ai][bj][m][1];
                    u32x4 w;
                    w.x = cvt_pk_bf16(bf_lo(a.x) + bf_lo(g.x) * c0[0], bf_hi(a.x) + bf_hi(g.x) * c0[1]);
                    w.y = cvt_pk_bf16(bf_lo(a.y) + bf_lo(g.y) * c0[2], bf_hi(a.y) + bf_hi(g.y) * c0[3]);
                    w.z = cvt_pk_bf16(bf_lo(a.z) + bf_lo(g.z) * c1[0], bf_hi(a.z) + bf_hi(g.z) * c1[1]);
                    w.w = cvt_pk_bf16(bf_lo(a.w) + bf_lo(g.w) * c1[2], bf_hi(a.w) + bf_hi(g.w) * c1[3]);
                    *(u32x4*)ap = w; }
            }
    }
};

struct EpiRes {
    static constexpr bool PERM = true;
    bf16_t* xb; float* ssq;
    __device__ __forceinline__ void operator()(const f32x4 (&acc)[2][2][4][2], const Unit& u, int wr, int wc, int fr, int fq) const {
        const int row0 = u.pm * BM + wr * 64 + fr, col0 = u.pn * BM + 32 * wc + 8 * fq;
#pragma unroll
        for (int ai = 0; ai < 2; ++ai)
#pragma unroll
            for (int m = 0; m < 4; ++m) {
                const int row = row0 + ai * HALF + m * 16;
                bf16_t* rp = xb + (size_t)row * D + col0;
                float ss = 0.f;
#pragma unroll
                for (int bj = 0; bj < 2; ++bj) {
                    const u32x4 b = *(const u32x4*)(rp + HALF * bj);
                    const f32x4 c0 = acc[ai][bj][m][0], c1 = acc[ai][bj][m][1];
                    const float x0 = bf_lo(b.x) + c0[0], x1 = bf_hi(b.x) + c0[1], x2 = bf_lo(b.y) + c0[2], x3 = bf_hi(b.y) + c0[3];
                    const float x4 = bf_lo(b.z) + c1[0], x5 = bf_hi(b.z) + c1[1], x6 = bf_lo(b.w) + c1[2], x7 = bf_hi(b.w) + c1[3];
                    ss += ((x0 * x0 + x1 * x1) + (x2 * x2 + x3 * x3)) + ((x4 * x4 + x5 * x5) + (x6 * x6 + x7 * x7));
                    u32x4 w; w.x = cvt_pk_bf16(x0, x1); w.y = cvt_pk_bf16(x2, x3); w.z = cvt_pk_bf16(x4, x5); w.w = cvt_pk_bf16(x6, x7);
                    *(u32x4*)(rp + HALF * bj) = w; }
                ss += __shfl_xor(ss, 16); ss += __shfl_xor(ss, 32);
                if (fq == 0) (void)__hip_atomic_fetch_add(ssq + row, ss, __ATOMIC_RELAXED, __HIP_MEMORY_SCOPE_AGENT);
            }
    }
};

__device__ __forceinline__ float dpp_ror1(float v) { return __int_as_float(__builtin_amdgcn_update_dpp(__float_as_int(v), __float_as_int(v), 0x121, 0xf, 0xf, false)); }
__device__ __forceinline__ float dpp_ror15(float v) { return __int_as_float(__builtin_amdgcn_update_dpp(__float_as_int(v), __float_as_int(v), 0x12F, 0xf, 0xf, false)); }
__device__ __forceinline__ f32x2 ror1_2(f32x2 v) { return (f32x2){dpp_ror1(v.x), dpp_ror1(v.y)}; }
__device__ __forceinline__ f32x2 ror15_2(f32x2 v) { return (f32x2){dpp_ror15(v.x), dpp_ror15(v.y)}; }
struct EpiUp {
    static constexpr bool PERM = true;
    bf16_t* G; const float* ssq2; const float* cw; const float* cb;
    struct CW { f32x2 g0, g1, g2, gb, v0, v1, v2, vb; };
    __device__ __forceinline__ void ldw(CW& w, int c) const {
        w.g0 = *(const f32x2*)(cw + c); w.g1 = *(const f32x2*)(cw + NUP + c); w.g2 = *(const f32x2*)(cw + 2 * NUP + c); w.gb = *(const f32x2*)(cb + c);
        w.v0 = *(const f32x2*)(cw + DFF + c); w.v1 = *(const f32x2*)(cw + NUP + DFF + c); w.v2 = *(const f32x2*)(cw + 2 * NUP + DFF + c); w.vb = *(const f32x2*)(cb + DFF + c); }
    static __device__ __forceinline__ float shr1(float v) { return __int_as_float(__builtin_amdgcn_update_dpp(0, __float_as_int(v), 0x111, 0xf, 0xf, true)); }
    static __device__ __forceinline__ float shl1(float v) { return __int_as_float(__builtin_amdgcn_update_dpp(0, __float_as_int(v), 0x101, 0xf, 0xf, true)); }
    __device__ __forceinline__ void operator()(const f32x4 (&acc)[2][2][4][2], const Unit& u, int wr, int wc, int fr, int fq) const {
        const int s_ = 2 * u.pm + wr, sg = s_ / 65, j = s_ - 65 * sg;
        const int tokb = 8192 * sg + 126 * j + 8 * fr;
        const int rlo = (j == 0) ? 0 : 1, rhi = (j == 64) ? 127 : 126;
        const bool mid = (j == 32) && (sg < 8), mz7 = mid && (fr == 7), mz8 = mid && (fr == 8);
        const int gcol = HALF * u.pn + 32 * wc + 8 * fq;
        CW wa, wb; ldw(wa, gcol);
        float rs[8];
#pragma unroll
        for (int blk = 0; blk < 8; ++blk) rs[blk] = __builtin_amdgcn_rsqf(ssq2[tokb + blk] * (1.0f / D) + EPS);
        unsigned outp[8][4];
        const f32x2 z2 = (f32x2){0.f, 0.f};
#pragma unroll
        for (int it = 0; it < 4; ++it) {
            const int n = it >> 1, ip = it & 1;
            if (it < 3) { if (it & 1) ldw(wa, gcol + 4 * ((it + 1) >> 1) + 2 * ((it + 1) & 1)); else ldw(wb, gcol + 4 * ((it + 1) >> 1) + 2 * ((it + 1) & 1)); }
            __builtin_amdgcn_sched_barrier(0);
            const CW& w = (it & 1) ? wb : wa;
#define UG(b_) ((f32x2){acc[(b_) >> 2][0][(b_) & 3][n][2 * ip], acc[(b_) >> 2][0][(b_) & 3][n][2 * ip + 1]} * rs[b_])
#define UV(b_) ((f32x2){acc[(b_) >> 2][1][(b_) & 3][n][2 * ip], acc[(b_) >> 2][1][(b_) & 3][n][2 * ip + 1]} * rs[b_])
            const f32x2 ug0 = UG(0), uv0 = UV(0), ug7 = UG(7), uv7 = UV(7);
            f32x2 pg = (f32x2){shr1(ug7.x), shr1(ug7.y)}, pv = (f32x2){shr1(uv7.x), shr1(uv7.y)};
            f32x2 eg = (f32x2){shl1(ug0.x), shl1(ug0.y)}, ev = (f32x2){shl1(uv0.x), shl1(uv0.y)};
            pg = mz8 ? z2 : pg; pv = mz8 ? z2 : pv; eg = mz7 ? z2 : eg; ev = mz7 ? z2 : ev;
            f32x2 cgu = ug0, cvu = uv0;
#pragma unroll
            for (int blk = 0; blk < 8; ++blk) {
                f32x2 ng, nv;
                if (blk < 7) { ng = UG(blk + 1); nv = UV(blk + 1); } else { ng = eg; nv = ev; }
                const f32x2 cgv = w.g2 * ng + (w.g1 * cgu + (w.g0 * pg + w.gb));
                const f32x2 cvv = w.v2 * nv + (w.v1 * cvu + (w.v0 * pv + w.vb));
                const f32x2 o = gelu_pk(cgv) * cvv;
                outp[blk][it] = cvt_pk_bf16(o.x, o.y);
                pg = cgu; pv = cvu; cgu = ng; cvu = nv;
            }
#undef UG
#undef UV
        }
#pragma unroll
        for (int blk = 0; blk < 8; ++blk) { const int rho = 8 * fr + blk;
            if (rho >= rlo && rho <= rhi) { u32x4 w4; w4.x = outp[blk][0]; w4.y = outp[blk][1]; w4.z = outp[blk][2]; w4.w = outp[blk][3];
                *(u32x4*)(G + (size_t)(tokb + blk) * DFF + gcol) = w4; } }
    }
};

struct EpiBf {
    static constexpr bool PERM = true;
    bf16_t* O;
    __device__ __forceinline__ void operator()(const f32x4 (&acc)[2][2][4][2], const Unit& u, int wr, int wc, int fr, int fq) const {
        const int row0 = u.pm * BM + wr * 64 + fr, col0 = u.pn * BM + 32 * wc + 8 * fq;
#pragma unroll
        for (int ai = 0; ai < 2; ++ai)
#pragma unroll
            for (int m = 0; m < 4; ++m) { bf16_t* rowp = O + (size_t)(row0 + ai * HALF + m * 16) * D + col0;
#pragma unroll
                for (int bj = 0; bj < 2; ++bj) { const f32x4 a = acc[ai][bj][m][0], b = acc[ai][bj][m][1];
                    u32x4 w; w.x = cvt_pk_bf16(a[0], a[1]); w.y = cvt_pk_bf16(a[2], a[3]); w.z = cvt_pk_bf16(b[0], b[1]); w.w = cvt_pk_bf16(b[2], b[3]);
                    *(u32x4*)(rowp + HALF * bj) = w; }
                asm volatile("" ::: "memory"); }
    }
};

struct EpiPg {
    static constexpr bool PERM = true;
    const bf16_t* X2; const bf16_t* PEMB; float* out; const float* ssq3; float* ssq4; unsigned* cnt; const float* gf;
    __device__ __forceinline__ void operator()(const f32x4 (&acc)[2][2][4][2], const Unit& u, int wr, int wc, int fr, int fq) const {
        const int row0 = u.pm * BM + wr * 64 + fr, col0 = u.pn * BM + 32 * wc + 8 * fq;
        f32x4 x[2][4][2][2];
#pragma unroll
        for (int ai = 0; ai < 2; ++ai)
#pragma unroll
            for (int m = 0; m < 4; ++m) {
                const int row = row0 + ai * HALF + m * 16;
                const float r3 = __builtin_amdgcn_rsqf(ssq3[row] * (1.0f / D) + EPS) * -1.44269504089f;
                float ss = 0.f;
#pragma unroll
                for (int bj = 0; bj < 2; ++bj) {
                    const size_t off = (size_t)row * D + col0 + HALF * bj;
                    const u32x4 pe = *(const u32x4*)(PEMB + off), b = *(const u32x4*)(X2 + off);
                    const f32x4 g0 = sigp4(acc[ai][bj][m][0] * r3), g1 = sigp4(acc[ai][bj][m][1] * r3);
                    const f32x4 a0 = (f32x4){bf_lo(b.x) + bf_lo(pe.x) * g0[0], bf_hi(b.x) + bf_hi(pe.x) * g0[1], bf_lo(b.y) + bf_lo(pe.y) * g0[2], bf_hi(b.y) + bf_hi(pe.y) * g0[3]};
                    const f32x4 a1 = (f32x4){bf_lo(b.z) + bf_lo(pe.z) * g1[0], bf_hi(b.z) + bf_hi(pe.z) * g1[1], bf_lo(b.w) + bf_lo(pe.w) * g1[2], bf_hi(b.w) + bf_hi(pe.w) * g1[3]};
                    x[ai][m][bj][0] = a0; x[ai][m][bj][1] = a1;
                    const f32x4 q0 = a0 * a0, q1 = a1 * a1; ss += ((q0[0] + q0[1]) + (q0[2] + q0[3])) + ((q1[0] + q1[1]) + (q1[2] + q1[3])); }
                ss += __shfl_xor(ss, 16); ss += __shfl_xor(ss, 32);
                if (fq == 0) (void)__hip_atomic_fetch_add(ssq4 + row, ss, __ATOMIC_RELAXED, __HIP_MEMORY_SCOPE_AGENT);
            }
        asm volatile("s_waitcnt vmcnt(0)" ::: "memory");
        unsigned* c = cnt + 64 * u.pm;
        if ((threadIdx.x & 63) == 0) (void)__hip_atomic_fetch_add(c, 1u, __ATOMIC_RELAXED, __HIP_MEMORY_SCOPE_AGENT);
        { unsigned sp = 0;
            while ((unsigned)__builtin_amdgcn_readfirstlane(__hip_atomic_load(c, __ATOMIC_RELAXED, __HIP_MEMORY_SCOPE_AGENT)) < 32u) { __builtin_amdgcn_s_sleep(8); if (++sp > (1u << 17)) break; } }
        f32x4 g[2][2];
#pragma unroll
        for (int bj = 0; bj < 2; ++bj) { g[bj][0] = *(const f32x4*)(gf + col0 + HALF * bj); g[bj][1] = *(const f32x4*)(gf + col0 + HALF * bj + 4); }
#pragma unroll
        for (int ai = 0; ai < 2; ++ai)
#pragma unroll
            for (int m = 0; m < 4; ++m) {
                const int row = row0 + ai * HALF + m * 16;
                const float r4 = __builtin_amdgcn_rsqf(__hip_atomic_load(ssq4 + row, __ATOMIC_RELAXED, __HIP_MEMORY_SCOPE_AGENT) * (1.0f / D) + EPS);
#pragma unroll
                for (int bj = 0; bj < 2; ++bj) { float* op = out + (size_t)row * D + col0 + HALF * bj;
                    *(f32x4*)op = x[ai][m][bj][0] * r4 * g[bj][0]; *(f32x4*)(op + 4) = x[ai][m][bj][1] * r4 * g[bj][1]; }
            }
    }
};
}

#define XB_TMO      128
#define XB_XCNT(j)  (256  + 64 * (j))
#define XB_XSUB(j)  (1280 + 64 * (j))
#define XB_XGEN(j)  (2304 + 64 * (j))
#define XB_TOP      3328
#define XB_TOPGEN   3392
#define XCD_BAR_WORDS 3456
#define XB_SPIN_CAP (1u << 18)
__device__ __forceinline__ unsigned xb_ld(unsigned* p)              { return __hip_atomic_load(p, __ATOMIC_RELAXED, __HIP_MEMORY_SCOPE_AGENT); }
__device__ __forceinline__ unsigned xb_add(unsigned* p, unsigned v) { return __hip_atomic_fetch_add(p, v, __ATOMIC_RELAXED, __HIP_MEMORY_SCOPE_AGENT); }
__device__ __forceinline__ unsigned xb_xcc_id() { return (unsigned)__builtin_amdgcn_s_getreg((3 << 11) | 20) & 0xFu; }
#define XB_SPIN(cond, bar) do { unsigned _sp = 0; while (cond) { __builtin_amdgcn_s_sleep(1); \
    if ((++_sp & 255u) == 0u) { if (xb_ld(&(bar)[XB_TMO])) break; if (_sp > XB_SPIN_CAP) { atomicAdd(&(bar)[XB_TMO], 1u); break; } } } } while (0)
struct XcdBarrier { unsigned* bar; unsigned x; volatile LAS unsigned* st; };
__device__ __forceinline__ XcdBarrier xcd_barrier_post(unsigned* bar, volatile LAS unsigned* st) {
    XcdBarrier b; b.bar = bar; b.x = xb_xcc_id(); b.st = st;
    if (threadIdx.x == 0) (void)xb_add(&bar[XB_XCNT(b.x)], 1u);
    return b;
}
__device__ __forceinline__ void xcd_barrier_complete(unsigned* bar, unsigned x, unsigned& nloc, unsigned& nx) {
    const unsigned G = gridDim.x * gridDim.y * gridDim.z;
    unsigned sum, cnt, mine, sp = 0u;
    for (;;) {
        sum = 0u; cnt = 0u; mine = 0u;
#pragma unroll
        for (unsigned j = 0; j < 16; ++j) { const unsigned c = xb_ld(&bar[XB_XCNT(j)]); sum += c; cnt += (c > 0u) ? 1u : 0u; mine = (j == x) ? c : mine; }
        if (sum == G) break;
        __builtin_amdgcn_s_sleep(1);
        if ((++sp & 255u) == 0u) { if (xb_ld(&bar[XB_TMO])) break; if (sp > XB_SPIN_CAP) { atomicAdd(&bar[XB_TMO], 1u); break; } }
    }
    nloc = mine > 0u ? mine : 1u; nx = cnt > 0u ? cnt : 1u;
}
__device__ __forceinline__ void xcd_barrier(const XcdBarrier& b) {
    asm volatile("s_waitcnt vmcnt(0)" ::: "memory");
    __syncthreads();
    if (threadIdx.x == 0) {
        unsigned* bar = b.bar;
        __builtin_amdgcn_s_waitcnt(0);
        unsigned nloc = b.st[0], nx = b.st[1];
        if (nloc == 0u) { xcd_barrier_complete(bar, b.x, nloc, nx); b.st[0] = nloc; b.st[1] = nx; }
        const unsigned old = xb_add(&bar[XB_XSUB(b.x)], 1u);
        const unsigned gen = old / nloc;
        if (old + 1u == (gen + 1u) * nloc) {
            __builtin_amdgcn_fence(__ATOMIC_RELEASE, "agent");
            asm volatile("s_waitcnt vmcnt(0)" ::: "memory");
            const unsigned og = xb_add(&bar[XB_TOP], 1u);
            const unsigned tg = og / nx;
            if (og + 1u == (tg + 1u) * nx) xb_add(&bar[XB_TOPGEN], 1u);
            else XB_SPIN(xb_ld(&bar[XB_TOPGEN]) == tg, bar);
            __builtin_amdgcn_fence(__ATOMIC_ACQUIRE, "agent");
            xb_add(&bar[XB_XGEN(b.x)], 1u);
            asm volatile("s_waitcnt vmcnt(0)" ::: "memory");
        } else {
            XB_SPIN(xb_ld(&bar[XB_XGEN(b.x)]) == gen, bar);
            __builtin_amdgcn_fence(__ATOMIC_ACQUIRE, "agent");
            asm volatile("s_waitcnt vmcnt(0)" ::: "memory");
        }
    }
    __syncthreads();
}

constexpr int NWAVES = 8, NTHR = 512;
constexpr int LDS_BYTES = 147456;
struct Args { const float* in[22]; float* out; unsigned char* ws; int ph_lo, ph_hi; };
using pg8::cvt_pk_bf16; using pg8::bf_lo; using pg8::bf_hi;

__device__ __forceinline__ float wave_sum(float v) {
#pragma unroll
    for (int o = 1; o < 64; o <<= 1) v += __shfl_xor(v, o);
    return v;
}
__device__ __forceinline__ void tr_item(const float* W, int K, int N, bf16_t* WT, int prow0, const float* gk, LAS float* scr, int k0, int n0, int lane) {
    float tv[32];
#pragma unroll
    for (int i = 0; i < 32; ++i) { const int kk = 2 * i + (lane >> 5); tv[i] = W[(size_t)(k0 + kk) * N + n0 + (lane & 31)]; }
    const float gsc = gk ? gk[k0 + lane] : 1.0f;
#pragma unroll
    for (int i = 0; i < 32; ++i) { const int kk = 2 * i + (lane >> 5); scr[kk * 33 + (lane & 31)] = tv[i] * __shfl(gsc, kk); }
    asm volatile("s_waitcnt lgkmcnt(0)" ::: "memory");
    const int c = lane & 7;
#pragma unroll
    for (int j = 0; j < 4; ++j) { const int n = (lane >> 3) + 8 * j; const LAS float* s = scr + (8 * c) * 33 + n;
        u32x4 o; o.x = cvt_pk_bf16(s[0 * 33], s[1 * 33]); o.y = cvt_pk_bf16(s[2 * 33], s[3 * 33]); o.z = cvt_pk_bf16(s[4 * 33], s[5 * 33]); o.w = cvt_pk_bf16(s[6 * 33], s[7 * 33]);
        *(u32x4*)(WT + (size_t)(prow0 + n) * K + k0 + 8 * c) = o; }
    asm volatile("s_waitcnt lgkmcnt(0)" ::: "memory");
}

__device__ __forceinline__ void p0_prologue(const Args& a, LAS unsigned char* lds, int wave, int lane) {
    unsigned char* ws = a.ws;
    LAS float* scr = (LAS float*)(lds + wave * 16384);
    const int gw = blockIdx.x * NWAVES + wave, NGW = gridDim.x * NWAVES;
    constexpr int I_IN = 16 * 112, I_UP = 16 * 176, I_DN = 44 * 32, I_O = 16 * 32, I_PG = 16 * 32, I_PE = 4 * 32, I_GP = 8 * 32, I_POOL = 4 * 16;
    constexpr int NITEMS = I_IN + I_UP + I_DN + I_O + I_PG + I_PE + I_GP + I_POOL;
    for (int it = gw; it < NITEMS; it += NGW) {
        int r = it;
        if (r < I_IN) { const int kb = r / 112, nb = r % 112, n0 = 32 * nb; int p = n0;
            if (n0 >= 1024 && n0 < 1536) { const int l = n0 - 1024, tv = l >> 8, w = l & 255, wc = w >> 6, bj = (w >> 5) & 1; p = 1024 + 256 * tv + 128 * bj + 32 * wc; }
            tr_item(a.in[5], D, DIN, (bf16_t*)(ws + WS_WIN), p, a.in[4], scr, 64 * kb, n0, lane); continue; } r -= I_IN;
        if (r < I_UP) { const int kb = r / 176, nb = r % 176, n0 = 32 * nb; int p;
            if (n0 < DFF) p = 256 * (n0 >> 7) + (n0 & 127); else { const int l = n0 - DFF; p = 256 * (l >> 7) + 128 + (l & 127); }
            tr_item(a.in[14], D, NUP, (bf16_t*)(ws + WS_WUP), p, a.in[13], scr, 64 * kb, n0, lane); continue; } r -= I_UP;
        if (r < I_DN) { const int kb = r / 32, nb = r % 32; tr_item(a.in[17], DFF, D, (bf16_t*)(ws + WS_WDN), 32 * nb, nullptr, scr, 64 * kb, 32 * nb, lane); continue; } r -= I_DN;
        if (r < I_O) { const int kb = r / 32, nb = r % 32; tr_item(a.in[12], D, D, (bf16_t*)(ws + WS_WO), 32 * nb, nullptr, scr, 64 * kb, 32 * nb, lane); continue; } r -= I_O;
        if (r < I_PG) { const int kb = r / 32, nb = r % 32; tr_item(a.in[20], D, D, (bf16_t*)(ws + WS_WPG), 32 * nb, a.in[18], scr, 64 * kb, 32 * nb, lane); continue; } r -= I_PG;
        if (r < I_PE) { const int kb = r / 32, nb = r % 32; tr_item(a.in[19], PLE, D, (bf16_t*)(ws + WS_WPE), 32 * nb, nullptr, scr, 64 * kb, 32 * nb, lane); continue; } r -= I_PE;
        if (r < I_GP) { const int kb = r / 32, nb = r % 32; tr_item(a.in[11], 512, D, (bf16_t*)(ws + WS_WGP), 32 * nb, nullptr, scr, 64 * kb, 32 * nb, lane); continue; } r -= I_GP;
        { const int g = r >> 4, rr = r & 15, kb = rr >> 3, nb = rr & 7;
          tr_item(a.in[6] + (size_t)g * 128 * 256, 128, 256, (bf16_t*)(ws + WS_POOLT) + (size_t)g * 256 * 128, 32 * nb, nullptr, scr, 64 * kb, 32 * nb, lane); }
    }
    if (gw == 0) for (int i = lane; i < 320; i += 64) ((unsigned*)(ws + WS_CNT))[64 * i] = 0u;
    for (int it = gw; it < 512; it += NGW) { const f32x4 v = *(const f32x4*)(a.in[9] + (size_t)it * 256 + lane * 4);
        u32x2 w; w.x = cvt_pk_bf16(v[0], v[1]); w.y = cvt_pk_bf16(v[2], v[3]); *(u32x2*)((bf16_t*)(ws + WS_SGUW) + (size_t)it * 256 + lane * 4) = w; }
    float* r1 = (float*)(ws + WS_R1); float* s2 = (float*)(ws + WS_SSQ2); float* s3 = (float*)(ws + WS_SSQ3); float* s4 = (float*)(ws + WS_SSQ4);
    bf16_t* XB = (bf16_t*)(ws + WS_XB); bf16_t* PB = (bf16_t*)(ws + WS_PB);
    for (int m0 = gw; m0 < T; m0 += 2 * NGW) {
        const int m1 = m0 + NGW; const bool two = m1 < T; const int mm1 = two ? m1 : m0;
        const float* xr0 = m0 < TP ? a.in[0] + (size_t)m0 * D : a.in[1] + (size_t)(m0 - TP) * D;
        const float* pr0 = m0 < TP ? a.in[2] + (size_t)m0 * PLE : a.in[3] + (size_t)(m0 - TP) * PLE;
        const float* xr1 = mm1 < TP ? a.in[0] + (size_t)mm1 * D : a.in[1] + (size_t)(mm1 - TP) * D;
        const float* pr1 = mm1 < TP ? a.in[2] + (size_t)mm1 * PLE : a.in[3] + (size_t)(mm1 - TP) * PLE;
        f32x4 v0[4], v1[4];
#pragma unroll
        for (int j = 0; j < 4; ++j) { v0[j] = *(const f32x4*)(xr0 + 256 * j + 4 * lane); v1[j] = *(const f32x4*)(xr1 + 256 * j + 4 * lane); }
        const f32x4 pv0 = *(const f32x4*)(pr0 + 4 * lane), pv1 = *(const f32x4*)(pr1 + 4 * lane);
        float s0 = 0.f, s1 = 0.f;
#pragma unroll
        for (int j = 0; j < 4; ++j) { const f32x4 q0 = v0[j] * v0[j], q1 = v1[j] * v1[j]; s0 += (q0[0] + q0[1]) + (q0[2] + q0[3]); s1 += (q1[0] + q1[1]) + (q1[2] + q1[3]); }
        s0 = wave_sum(s0); s1 = wave_sum(s1);
#pragma unroll
        for (int j = 0; j < 4; ++j) { u32x2 w; w.x = cvt_pk_bf16(v0[j][0], v0[j][1]); w.y = cvt_pk_bf16(v0[j][2], v0[j][3]); *(u32x2*)(XB + (size_t)m0 * D + 256 * j + 4 * lane) = w; }
        { u32x2 w; w.x = cvt_pk_bf16(pv0[0], pv0[1]); w.y = cvt_pk_bf16(pv0[2], pv0[3]); *(u32x2*)(PB + (size_t)m0 * PLE + 4 * lane) = w; }
        if (lane == 0) { r1[m0] = __builtin_amdgcn_rsqf(s0 * (1.0f / D) + EPS); s2[m0] = 0.f; s3[m0] = 0.f; s4[m0] = 0.f; }
        if (two) {
#pragma unroll
            for (int j = 0; j < 4; ++j) { u32x2 w; w.x = cvt_pk_bf16(v1[j][0], v1[j][1]); w.y = cvt_pk_bf16(v1[j][2], v1[j][3]); *(u32x2*)(XB + (size_t)m1 * D + 256 * j + 4 * lane) = w; }
            { u32x2 w; w.x = cvt_pk_bf16(pv1[0], pv1[1]); w.y = cvt_pk_bf16(pv1[2], pv1[3]); *(u32x2*)(PB + (size_t)m1 * PLE + 4 * lane) = w; }
            if (lane == 0) { r1[m1] = __builtin_amdgcn_rsqf(s1 * (1.0f / D) + EPS); s2[m1] = 0.f; s3[m1] = 0.f; s4[m1] = 0.f; }
        }
    }
}

struct P2Stage { u32x4 z[5]; u32x4 v[2][2]; };
__device__ __forceinline__ void p2_fetch(P2Stage& st, const bf16_t* PROJ, int uid, int tid, int wave, int lane) {
    const int chunk = uid >> 2, q = uid & 3, t0 = chunk * 128;
    const int seqmask = t0 < TP ? 4095 : 8191;
    const bool at_start = (t0 & seqmask) == 0, at_end = ((t0 + 128) & seqmask) == 0;
#pragma unroll
    for (int k = 0; k < 5; ++k) { const int p = tid + NTHR * k; const int r = p >> 4, o = p & 15; const int t = t0 - 8 + r;
        const bool ok = (p < 144 * 16) && !((r < 8 && at_start) || (r >= 136 && at_end));
        st.z[k] = (u32x4){0u, 0u, 0u, 0u}; if (ok) st.z[k] = *(const u32x4*)(PROJ + (size_t)t * DIN + 128 * q + 8 * o); }
#pragma unroll
    for (int h2 = 0; h2 < 2; ++h2) { const bf16_t* src = PROJ + (size_t)(t0 + 2 * lane) * DIN + 1024 + 64 * (2 * q + h2) + 8 * wave;
        st.v[h2][0] = *(const u32x4*)src; st.v[h2][1] = *(const u32x4*)(src + DIN); }
}
__device__ __forceinline__ void p2_mixers(const Args& a, LAS unsigned char* lds, int tid, int wave, int lane) {
    unsigned char* ws = a.ws;
    const bf16_t* PROJ = (const bf16_t*)(ws + WS_PROJ); bf16_t* AG = (bf16_t*)(ws + WS_MG); bf16_t* GATED = (bf16_t*)a.out;
    const bf16_t* POOLT = (const bf16_t*)(ws + WS_POOLT); const bf16_t* SGUW = (const bf16_t*)(ws + WS_SGUW);
    const float* pool_scale = a.in[7]; const float* sgu_b = a.in[10];
    LAS unsigned char* zt = lds; LAS unsigned char* dt = lds + 36864; LAS unsigned char* vt = lds + 36864 + 34816;
    const int fr = lane & 15, fq = lane >> 4;
    P2Stage st;
    if ((int)blockIdx.x < 2560) p2_fetch(st, PROJ, blockIdx.x, tid, wave, lane);
    for (int uid = blockIdx.x; uid < 2560; uid += gridDim.x) {
        const int chunk = uid >> 2, q = uid & 3, t0 = chunk * 128;
        const int seqmask = t0 < TP ? 4095 : 8191;
        const bool at_start = (t0 & seqmask) == 0, at_end = ((t0 + 128) & seqmask) == 0;
#pragma unroll
        for (int k = 0; k < 5; ++k) { const int p = tid + NTHR * k; if (p < 144 * 16) *(LAS u32x4*)(zt + (p >> 4) * 256 + (p & 15) * 16) = st.z[k]; }
#pragma unroll
        for (int h2 = 0; h2 < 2; ++h2) { const u32x4 v0 = st.v[h2][0], v1 = st.v[h2][1];
            LAS unsigned char* dst = vt + (h2 * 64 + 8 * wave) * 272 + 4 * lane;
            *(LAS unsigned*)(dst + 0 * 272) = (v0.x & 0xffffu) | (v1.x << 16); *(LAS unsigned*)(dst + 1 * 272) = (v0.x >> 16) | (v1.x & 0xffff0000u);
            *(LAS unsigned*)(dst + 2 * 272) = (v0.y & 0xffffu) | (v1.y << 16); *(LAS unsigned*)(dst + 3 * 272) = (v0.y >> 16) | (v1.y & 0xffff0000u);
            *(LAS unsigned*)(dst + 4 * 272) = (v0.z & 0xffffu) | (v1.z << 16); *(LAS unsigned*)(dst + 5 * 272) = (v0.z >> 16) | (v1.z & 0xffff0000u);
            *(LAS unsigned*)(dst + 6 * 272) = (v0.w & 0xffffu) | (v1.w << 16); *(LAS unsigned*)(dst + 7 * 272) = (v0.w >> 16) | (v1.w & 0xffff0000u); }
        bf16x8 wf[2][4], sf[2][4];
        const int h2w = wave >> 2, ts = 32 * (wave & 3), hh = 2 * q + h2w;
#pragma unroll
        for (int nb = 0; nb < 2; ++nb)
#pragma unroll
            for (int ks = 0; ks < 4; ++ks) { const int row = 32 * wave + 8 * (fr >> 2) + 4 * nb + (fr & 3);
                wf[nb][ks] = *(const bf16x8*)(POOLT + ((size_t)(q * 256 + row)) * 128 + 32 * ks + 8 * fq); }
        const int col = 256 * q + 32 * wave + 8 * fq;
        u32x4 gg[8], uu[2][2]; float bb[2];
#pragma unroll
        for (int mb = 0; mb < 8; ++mb) gg[mb] = *(const u32x4*)(PROJ + (size_t)(t0 + 16 * mb + fr) * DIN + 1536 + col);
        __syncthreads();
        { const int half = 1 << q, tau0 = 16 * wave; const LAS unsigned* zd = (const LAS unsigned*)zt; LAS unsigned* dd = (LAS unsigned*)dt;
            float s0 = 0.f, s1 = 0.f;
            for (int r = tau0 + 8 - half; r < tau0 + 8 + half; ++r) { const unsigned w = zd[r * 64 + lane]; s0 += bf_lo(w); s1 += bf_hi(w); }
#pragma unroll 4
            for (int k = 0; k < 16; ++k) { const int tau = tau0 + k;
                int cnt = 2 * half; if (at_start) { const int o = half - tau; cnt -= o > 0 ? o : 0; } if (at_end) { const int o = tau + half - 128; cnt -= o > 0 ? o : 0; }
                const float inv = 1.0f / (float)cnt;
                const unsigned wcn = zd[(tau + 8) * 64 + lane];
                dd[tau * 68 + lane] = cvt_pk_bf16(s0 * inv - bf_lo(wcn), s1 * inv - bf_hi(wcn));
                const unsigned wl = zd[(tau + 8 - half) * 64 + lane], wh = zd[(tau + 8 + half) * 64 + lane];
                s0 += bf_lo(wh) - bf_lo(wl); s1 += bf_hi(wh) - bf_hi(wl); }
        }
        __syncthreads();
        if (uid + (int)gridDim.x < 2560) p2_fetch(st, PROJ, uid + gridDim.x, tid, wave, lane);
        { f32x4 acc[8][2];
#pragma unroll
            for (int mb = 0; mb < 8; ++mb) { acc[mb][0] = (f32x4){0.f, 0.f, 0.f, 0.f}; acc[mb][1] = (f32x4){0.f, 0.f, 0.f, 0.f}; }
#pragma unroll
            for (int mb = 0; mb < 8; ++mb)
#pragma unroll
                for (int ks = 0; ks < 4; ++ks) { const bf16x8 df = *(const LAS bf16x8*)(dt + (16 * mb + fr) * 272 + (32 * ks + 8 * fq) * 2);
                    acc[mb][0] = __builtin_amdgcn_mfma_f32_16x16x32_bf16(wf[0][ks], df, acc[mb][0], 0, 0, 0);
                    acc[mb][1] = __builtin_amdgcn_mfma_f32_16x16x32_bf16(wf[1][ks], df, acc[mb][1], 0, 0, 0); }
#pragma unroll
            for (int mb = 0; mb < 2; ++mb)
#pragma unroll
                for (int ks = 0; ks < 4; ++ks) sf[mb][ks] = *(const bf16x8*)(SGUW + ((size_t)hh * 128 + ts + 16 * mb + fr) * 128 + 32 * ks + 8 * fq);
#pragma unroll
            for (int mb = 0; mb < 2; ++mb) { const int tau = ts + 16 * mb + fr; bb[mb] = sgu_b[hh * 128 + tau];
#pragma unroll
                for (int hf = 0; hf < 2; ++hf) uu[mb][hf] = *(const u32x4*)(PROJ + (size_t)(t0 + tau) * DIN + 512 + 64 * hh + 32 * hf + 8 * fq); }
            const f32x4 sc0 = *(const f32x4*)(pool_scale + col), sc1 = *(const f32x4*)(pool_scale + col + 4);
#pragma unroll
            for (int mb = 0; mb < 8; ++mb) { const size_t t = (size_t)(t0 + 16 * mb + fr);
                const u32x4 g = gg[mb];
                const f32x4 x0 = acc[mb][0] * sc0, x1 = acc[mb][1] * sc1;
                u32x4 w; w.x = cvt_pk_bf16(x0[0] * pg8::sigp(bf_lo(g.x)), x0[1] * pg8::sigp(bf_hi(g.x))); w.y = cvt_pk_bf16(x0[2] * pg8::sigp(bf_lo(g.y)), x0[3] * pg8::sigp(bf_hi(g.y)));
                w.z = cvt_pk_bf16(x1[0] * pg8::sigp(bf_lo(g.z)), x1[1] * pg8::sigp(bf_hi(g.z))); w.w = cvt_pk_bf16(x1[2] * pg8::sigp(bf_lo(g.w)), x1[3] * pg8::sigp(bf_hi(g.w)));
                *(u32x4*)(AG + t * D + col) = w; }
        }
        { f32x4 acc[2][4];
#pragma unroll
            for (int mb = 0; mb < 2; ++mb)
#pragma unroll
                for (int nb = 0; nb < 4; ++nb) acc[mb][nb] = (f32x4){0.f, 0.f, 0.f, 0.f};
#pragma unroll
            for (int nb = 0; nb < 4; ++nb)
#pragma unroll
                for (int ks = 0; ks < 4; ++ks) { const int crow = 32 * (nb >> 1) + 8 * (fr >> 2) + 4 * (nb & 1) + (fr & 3);
                    const bf16x8 vf = *(const LAS bf16x8*)(vt + (h2w * 64 + crow) * 272 + (32 * ks + 8 * fq) * 2);
                    acc[0][nb] = __builtin_amdgcn_mfma_f32_16x16x32_bf16(vf, sf[0][ks], acc[0][nb], 0, 0, 0);
                    acc[1][nb] = __builtin_amdgcn_mfma_f32_16x16x32_bf16(vf, sf[1][ks], acc[1][nb], 0, 0, 0); }
#pragma unroll
            for (int mb = 0; mb < 2; ++mb) { const int tau = ts + 16 * mb + fr; const size_t t = (size_t)(t0 + tau); const float b = bb[mb];
#pragma unroll
                for (int hf = 0; hf < 2; ++hf) { const int cb_ = 64 * hh + 32 * hf + 8 * fq;
                    const u32x4 u_ = uu[mb][hf];
                    const f32x4 x0 = acc[mb][2 * hf] + b, x1 = acc[mb][2 * hf + 1] + b;
                    const f32x2 ua = pg8::gelu_pk((f32x2){bf_lo(u_.x), bf_hi(u_.x)}), ub = pg8::gelu_pk((f32x2){bf_lo(u_.y), bf_hi(u_.y)});
                    const f32x2 uc = pg8::gelu_pk((f32x2){bf_lo(u_.z), bf_hi(u_.z)}), ud = pg8::gelu_pk((f32x2){bf_lo(u_.w), bf_hi(u_.w)});
                    u32x4 w; w.x = cvt_pk_bf16(x0[0] * ua.x, x0[1] * ua.y); w.y = cvt_pk_bf16(x0[2] * ub.x, x0[3] * ub.y);
                    w.z = cvt_pk_bf16(x1[0] * uc.x, x1[1] * uc.y); w.w = cvt_pk_bf16(x1[2] * ud.x, x1[3] * ud.y);
                    *(u32x4*)(GATED + t * 512 + cb_) = w; } }
        }
        __syncthreads();
    }
}

__global__ void __launch_bounds__(NTHR, 2) fwd_mega(Args a) {
    extern __shared__ __attribute__((aligned(16))) unsigned char lds_raw[];
    LAS unsigned char* lds = (LAS unsigned char*)lds_raw;
    cg::grid_group grid = cg::this_grid();
    const int tid = threadIdx.x, lane = tid & 63, wave = __builtin_amdgcn_readfirstlane(tid >> 6);
    const int G = gridDim.x, bx = blockIdx.x;
    unsigned char* ws = a.ws;
    const int lo = a.ph_lo, hi = a.ph_hi;
    volatile LAS unsigned* MISC = (volatile LAS unsigned*)(lds + 131072 + 1024);
    unsigned* barw = (unsigned*)(ws + WS_BAR);
    if (tid < 4) MISC[tid] = 0u;
    __syncthreads();
    XcdBarrier xbar = xcd_barrier_post(barw, MISC);
    if (lo < 0) grid.sync();
#define IN(k) (lo <= (k) && (k) < hi)
#define SEAM(k) do { if (IN(k) && IN((k) + 1)) xcd_barrier(xbar); } while (0)
    if (IN(0)) { p0_prologue(a, lds, wave, lane); } SEAM(0);
    if (IN(1)) { pg8::Gemm g{(const bf16_t*)(ws + WS_XB), (const bf16_t*)(ws + WS_WIN), D, 0}; pg8::StaticOrder S; S.init(T / 256, DIN / 256, G, bx);
        pg8::EpiProj E{(bf16_t*)(ws + WS_PROJ), (const float*)(ws + WS_R1), a.in[8]};
        pg8::gemm_phase<pg8::EpiProj, pg8::StaticOrder, true, true>(lds, g, S, E); } SEAM(1);
    if (IN(2)) { p2_mixers(a, lds, tid, wave, lane); } SEAM(2);
    if (IN(3)) { pg8::Gemm g{(const bf16_t*)a.out, (const bf16_t*)(ws + WS_WGP), 512, 0}; pg8::StaticOrder S; S.init(T / 256, D / 256, G, bx);
        pg8::EpiMerge E{(bf16_t*)(ws + WS_MG), (const bf16_t*)(ws + WS_PROJ)};
        pg8::gemm_phase<pg8::EpiMerge, pg8::StaticOrder, true, true>(lds, g, S, E); } SEAM(3);
    if (IN(4)) { pg8::Gemm g{(const bf16_t*)(ws + WS_MG), (const bf16_t*)(ws + WS_WO), D, 0}; pg8::StaticOrder S; S.init(T / 256, D / 256, G, bx);
        pg8::EpiRes E{(bf16_t*)(ws + WS_XB), (float*)(ws + WS_SSQ2)};
        pg8::gemm_phase<pg8::EpiRes, pg8::StaticOrder, true, true>(lds, g, S, E); } SEAM(4);
    if (IN(5)) { pg8::Gemm g{(const bf16_t*)(ws + WS_XB), (const bf16_t*)(ws + WS_WUP), D, 1}; pg8::StaticOrder S; S.init(325, NUP / 256, G, bx);
        pg8::EpiUp E{(bf16_t*)(ws + WS_PROJ), (const float*)(ws + WS_SSQ2), a.in[15], a.in[16]};
        pg8::gemm_phase<pg8::EpiUp, pg8::StaticOrder, true, true>(lds, g, S, E);
        pg8::Gemm g2{(const bf16_t*)(ws + WS_PB), (const bf16_t*)(ws + WS_WPE), PLE, 0}; pg8::StaticOrder S2; S2.init(T / 256, D / 256, G, bx);
        pg8::EpiBf E2{(bf16_t*)(ws + WS_MG)};
        pg8::gemm_phase<pg8::EpiBf, pg8::StaticOrder, true, true>(lds, g2, S2, E2); } SEAM(5);
    if (IN(6)) { pg8::Gemm g{(const bf16_t*)(ws + WS_PROJ), (const bf16_t*)(ws + WS_WDN), DFF, 0}; pg8::StaticOrder S; S.init(T / 256, D / 256, G, bx);
        pg8::EpiRes E{(bf16_t*)(ws + WS_XB), (float*)(ws + WS_SSQ3)};
        pg8::gemm_phase<pg8::EpiRes, pg8::StaticOrder, true, true>(lds, g, S, E); } SEAM(6);
    if (IN(7)) { pg8::Gemm g{(const bf16_t*)(ws + WS_XB), (const bf16_t*)(ws + WS_WPG), D, 0}; pg8::StaticOrder S; S.init(T / 256, D / 256, G, bx);
        pg8::EpiPg E{(const bf16_t*)(ws + WS_XB), (const bf16_t*)(ws + WS_MG), a.out, (const float*)(ws + WS_SSQ3), (float*)(ws + WS_SSQ4), (unsigned*)(ws + WS_CNT), a.in[21]};
        pg8::gemm_phase<pg8::EpiPg, pg8::StaticOrder, true, true>(lds, g, S, E); }
#undef IN
#undef SEAM
}

#ifndef MK_N_LAUNCHES
#define MK_N_LAUNCHES 1
#endif
extern "C" void kernel_launch(void* const* d_in, const int* in_sizes, int n_in, void* d_out, int out_size, void* d_ws, size_t ws_size, hipStream_t stream) {
    static int grid = 0;
    if (grid == 0) {
        if (n_in != 22 || out_size != T * D || ws_size < WS_END) { fprintf(stderr, "kernel_launch: unexpected shapes: n_in %d out %d ws %zu\n", n_in, out_size, ws_size); grid = -1; return; }
        int dev = 0, cus = 0, per_cu = 0;
        (void)hipGetDevice(&dev); (void)hipDeviceGetAttribute(&cus, hipDeviceAttributeMultiprocessorCount, dev);
        if (hipFuncSetAttribute((const void*)fwd_mega, hipFuncAttributeMaxDynamicSharedMemorySize, LDS_BYTES) != hipSuccess) { fprintf(stderr, "kernel_launch: hipFuncSetAttribute failed\n"); grid = -1; return; }
        if (hipOccupancyMaxActiveBlocksPerMultiprocessor(&per_cu, (const void*)fwd_mega, NTHR, LDS_BYTES) != hipSuccess || per_cu < 1) { fprintf(stderr, "kernel_launch: occupancy query says %d\n", per_cu); per_cu = 1; }
        (void)hipGetLastError();
        grid = cus * 1;
        if (grid <= 0) grid = 256;
    }
    if (grid < 0) return;
    if (hipMemsetAsync((char*)d_ws + WS_BAR, 0, XCD_BAR_WORDS * 4, stream) != hipSuccess) { fprintf(stderr, "kernel_launch: memset of the barrier words failed\n"); return; }
    Args a{};
    for (int i = 0; i < 22; ++i) a.in[i] = (const float*)d_in[i];
    a.out = (float*)d_out; a.ws = (unsigned char*)d_ws;
#if MK_N_LAUNCHES == 1
    a.ph_lo = 0; a.ph_hi = NPH;
    void* args[] = {&a};
    hipError_t e = hipLaunchCooperativeKernel((const void*)fwd_mega, dim3(grid), dim3(NTHR), args, LDS_BYTES, stream);
    if (e != hipSuccess) fprintf(stderr, "kernel_launch: cooperative launch failed: %s (grid %d)\n", hipGetErrorString(e), grid);
#endif
#ifdef PROBE_PHASE
    a.ph_lo = PROBE_PHASE; a.ph_hi = PROBE_PHASE + 1; hipLaunchKernelGGL(fwd_mega, dim3(grid), dim3(NTHR), LDS_BYTES, stream, a);
#endif
}
```

```cpp
#include <hip/hip_runtime.h>
#include <hip/hip_cooperative_groups.h>
#include <cstdio>
#include <cstdint>
namespace cg = cooperative_groups;

#define LAS __attribute__((address_space(3)))
typedef unsigned short bf16_t;
typedef short bf16x8 __attribute__((ext_vector_type(8)));
typedef float f32x4 __attribute__((ext_vector_type(4)));
typedef float f32x2 __attribute__((ext_vector_type(2)));
typedef unsigned u32x4 __attribute__((ext_vector_type(4)));
typedef unsigned u32x2 __attribute__((ext_vector_type(2)));

constexpr int T = 81920, TP = 65536, D = 1024, DIN = 3584, DFF = 2816, NUP = 5632, PLE = 256;
constexpr float EPS = 1e-6f;
constexpr int NPH = 8;
constexpr size_t MiB = 1u << 20;
constexpr size_t WS_R1 = 0, WS_SSQ2 = WS_R1 + (size_t)T * 4, WS_SSQ3 = WS_SSQ2 + (size_t)T * 4, WS_SSQ4 = WS_SSQ3 + (size_t)T * 4;
constexpr size_t WS_CNT = WS_SSQ4 + (size_t)T * 4;
constexpr size_t WS_BAR = 1536 * 1024;
constexpr size_t WS_WIN = 2 * MiB;
constexpr size_t WS_WUP = WS_WIN + (size_t)DIN * D * 2;
constexpr size_t WS_WDN = WS_WUP + (size_t)NUP * D * 2;
constexpr size_t WS_WO = WS_WDN + (size_t)D * DFF * 2;
constexpr size_t WS_WPG = WS_WO + (size_t)D * D * 2;
constexpr size_t WS_WPE = WS_WPG + (size_t)D * D * 2;
constexpr size_t WS_WGP = WS_WPE + (size_t)D * PLE * 2;
constexpr size_t WS_POOLT = WS_WGP + (size_t)D * 512 * 2;
constexpr size_t WS_SGUW = WS_POOLT + (size_t)4 * 256 * 128 * 2;
constexpr size_t WS_PB = 32 * MiB;
constexpr size_t WS_XB = 73 * MiB;
constexpr size_t WS_MG = 234 * MiB;
constexpr size_t WS_PROJ = 394 * MiB;
constexpr size_t WS_END = 954 * MiB;
static_assert(WS_SGUW + 8 * 128 * 128 * 2 <= WS_PB && WS_CNT + 320 * 256 <= WS_BAR, "weights / control words fit");

namespace pg8 {
constexpr int BM = 256, BK = 64, HALF = 128, HTB = HALF * BK * 2, STAGE_BYTES = 8 * HTB, NXCD = 8, WGM = 8;
__host__ __device__ __forceinline__ int lds_byte(int r, int c) { const int st = (r >> 4) * 2 + (c >> 5), rr = r & 15, cc = c & 31, ob = rr * 64 + cc * 2; return st * 1024 + (ob ^ (((ob >> 9) & 1) << 5)); }
__host__ __device__ __forceinline__ void stage_rc(int b, int& R, int& C) { const int st = b / 1024, sb = b % 1024, swz = sb ^ (((sb >> 9) & 1) << 5); R = (st >> 1) * 16 + swz / 64; C = (st & 1) * 32 + (swz % 64) / 2; }
__host__ __device__ __forceinline__ int perm32(int rho) { const int n = rho >> 4, i = rho & 15; return 8 * (i >> 2) + 4 * n + (i & 3); }

struct Unit { int pm, pn; };
struct Gemm { const bf16_t* A; const bf16_t* Bt; int K; int seg; };
__host__ __device__ __forceinline__ int seg_bt(int s) { const int sg = s / 65, j = s - 65 * sg; return 8192 * sg + 126 * j; }

struct StaticOrder {
    int nM, nN, nwg, G, c;
    __host__ __device__ void init(int nM_, int nN_, int G_, int c_) { nM = nM_; nN = nN_; nwg = nM * nN; G = G_; c = c_; }
    __host__ __device__ bool next(int i, Unit& u) const {
        const long L = (long)i * G + c; if (L >= nwg) return false;
        int wgid = (int)L; { const int q = nwg / NXCD, r = nwg % NXCD, xcd = wgid % NXCD, off = wgid / NXCD; wgid = (xcd < r ? xcd * (q + 1) : r * (q + 1) + (xcd - r) * q) + off; }
        const int nig = WGM * nN, gid = wgid / nig, fm = gid * WGM, gsz = (nM - fm) < WGM ? (nM - fm) : WGM;
        u.pm = fm + ((wgid % nig) % gsz); u.pn = (wgid % nig) / gsz; return true;
    }
    __device__ __forceinline__ void a_ready(const Unit&) const {}
    __device__ __forceinline__ void done(const Unit&) const {}
};

__device__ __forceinline__ unsigned cvt_pk_bf16(float lo, float hi) { unsigned r; asm volatile("v_cvt_pk_bf16_f32 %0, %1, %2" : "=v"(r) : "v"(lo), "v"(hi)); return r; }
__device__ __forceinline__ f32x2 gelu_pk(f32x2 v) {
    f32x2 z = v * 0.70710678118f;
    z.x = __builtin_amdgcn_fmed3f(z.x, -3.832506856900711f, 3.832506856900711f); z.y = __builtin_amdgcn_fmed3f(z.y, -3.832506856900711f, 3.832506856900711f);
    const f32x2 z2 = z * z;
    f32x2 p = z2 * 0.00022905065861350646f + 0.0034082910107109506f; p = p * z2 + 0.050955695062380861f; p = p * z2 + 0.18520832239976145f; p = p * z2 + 1.128379143519084f;
    f32x2 q = z2 * -1.1791602954361697e-7f + 0.000023547966471313185f; q = q * z2 + 0.0010179625278914885f; q = q * z2 + 0.014070470171167667f; q = q * z2 + 0.11098505178285362f; q = q * z2 + 0.49746925110067538f; q = q * z2 + 1.0f;
    f32x2 r; r.x = __builtin_amdgcn_rcpf(q.x); r.y = __builtin_amdgcn_rcpf(q.y);
    const f32x2 e = (z * p) * r, hv = v * 0.5f;
    return hv * e + hv;
}
__device__ __forceinline__ f32x4 gelu4(f32x4 v) { const f32x2 a = gelu_pk((f32x2){v[0], v[1]}), b = gelu_pk((f32x2){v[2], v[3]}); return (f32x4){a.x, a.y, b.x, b.y}; }
__device__ __forceinline__ float sigm(float x) { return __builtin_amdgcn_rcpf(1.0f + __builtin_amdgcn_exp2f(x * -1.44269504089f)); }
__device__ __forceinline__ f32x4 sigm4(f32x4 v) { return (f32x4){sigm(v[0]), sigm(v[1]), sigm(v[2]), sigm(v[3])}; }
__device__ __forceinline__ float sigp(float y) { return __builtin_amdgcn_rcpf(1.0f + __builtin_amdgcn_exp2f(y)); }
__device__ __forceinline__ f32x4 sigp4(f32x4 v) { return (f32x4){sigp(v[0]), sigp(v[1]), sigp(v[2]), sigp(v[3])}; }
__device__ __forceinline__ float bf_lo(unsigned w) { return __uint_as_float(w << 16); }
__device__ __forceinline__ float bf_hi(unsigned w) { return __uint_as_float(w & 0xffff0000u); }

template <class Epi, class Sched, bool ALIGN_EPI = false, bool SP2 = false>
__device__ __forceinline__ void gemm_phase(LAS unsigned char* lds, const Gemm g, const Sched& S, const Epi& E) {
    const int tid = threadIdx.x, wid = __builtin_amdgcn_readfirstlane(tid >> 6), lane = tid & 63, wr = wid >> 2, wc = wid & 3, fr = lane & 15, fq = lane >> 4;
    const int K = g.K, nt = K / BK;
    unsigned voffA[2], voffB[2];
#pragma unroll
    for (int i = 0; i < 2; ++i) { int R, C; stage_rc(tid * 16 + i * 8192, R, C); const int Rb = Epi::PERM ? ((R & ~31) + perm32(R & 31)) : R;
        const int Ra = g.seg ? (8 * (R & 15) + ((R >> 4) & 3)) : (R & 63);
        voffA[i] = (unsigned)(Ra * K + C) * 2u; voffB[i] = (unsigned)(Rb * K + C) * 2u; }
    const size_t kstep = (size_t)(BK * 2);
    const size_t hstep = (size_t)HALF * K * 2;
    const size_t tstep = 2 * hstep;
    const size_t rowb = (size_t)K * 2;
    const size_t hstepA = (g.seg ? 4 : 128) * rowb;
#define PG8_ABASE(pm_) ((const char*)g.A + (size_t)(g.seg ? seg_bt(2 * (pm_)) : 256 * (pm_)) * rowb)
#define PG8_AGAP(pm_) ((size_t)(g.seg ? (seg_bt(2 * (pm_) + 1) - seg_bt(2 * (pm_))) : 64) * rowb)
    const unsigned ldsw = (unsigned)wid * 1024u;
    const int aoff = lds_byte(wr * 64 + fr, fq * 8), boff = lds_byte(wc * 32 + fr, fq * 8);
#define PG8_SA(b, h) (((b) * 2 + (h)) * HTB)
#define PG8_SB(b, h) ((4 + (b) * 2 + (h)) * HTB)
#define PG8_STAGE(bufoff, gbase, voff) do { _Pragma("unroll") for (int _i = 0; _i < 2; ++_i) \
        __builtin_amdgcn_global_load_lds((const unsigned*)((const char*)(gbase) + (voff)[_i]), (LAS unsigned*)(lds + (bufoff) + ldsw + _i * 8192), 16, 0, 0); } while (0)
#define PG8_STAGE_A(bufoff, gbase, gapb) do { _Pragma("unroll") for (int _i = 0; _i < 2; ++_i) \
        __builtin_amdgcn_global_load_lds((const unsigned*)((const char*)(gbase) + (size_t)_i * (gapb) + voffA[_i]), (LAS unsigned*)(lds + (bufoff) + ldsw + _i * 8192), 16, 0, 0); } while (0)
#define PG8_LDA(dst, b, h) do { _Pragma("unroll") for (int m = 0; m < 4; ++m) _Pragma("unroll") for (int k = 0; k < 2; ++k) dst[m][k] = *(const LAS bf16x8*)(lds + PG8_SA(b, h) + aoff + m * 2048 + k * 1024); } while (0)
#define PG8_LDB(dst, b, h) do { _Pragma("unroll") for (int n = 0; n < 2; ++n) _Pragma("unroll") for (int k = 0; k < 2; ++k) dst[n][k] = *(const LAS bf16x8*)(lds + PG8_SB(b, h) + boff + n * 2048 + k * 1024); } while (0)
#define PG8_MMA(ai, bj, At, Bt) do { __builtin_amdgcn_s_setprio(1); _Pragma("unroll") for (int k = 0; k < 2; ++k) _Pragma("unroll") for (int n = 0; n < 2; ++n) { _Pragma("unroll") for (int m = 0; m < 4; ++m) \
        acc[ai][bj][m][n] = __builtin_amdgcn_mfma_f32_16x16x32_bf16(Bt[n][k], At[m][k], acc[ai][bj][m][n], 0, 0, 0); __builtin_amdgcn_sched_group_barrier(0x8, 4, 0); } __builtin_amdgcn_s_setprio(0); } while (0)
#define PG8_WAIT_V(n) asm volatile("s_waitcnt vmcnt(" #n ")" ::: "memory")
#define PG8_WAIT_L(n) asm volatile("s_waitcnt lgkmcnt(" #n ")" ::: "memory")
#define PG8_BAR __builtin_amdgcn_s_barrier()
#define PG8_SCHED __builtin_amdgcn_sched_barrier(0)
    Unit cur, nxt; int ui = 0;
    if (!S.next(0, cur)) return;
    f32x4 acc[2][2][4][2];
#pragma unroll
    for (int a = 0; a < 2; ++a)
#pragma unroll
        for (int b = 0; b < 2; ++b)
#pragma unroll
            for (int m = 0; m < 4; ++m)
#pragma unroll
                for (int n = 0; n < 2; ++n) acc[a][b][m][n] = (f32x4){0.f, 0.f, 0.f, 0.f};
    bf16x8 At[4][2], B0[2][2], B1[2][2];
    const char* cA = PG8_ABASE(cur.pm); size_t cG = PG8_AGAP(cur.pm); const char* cB = (const char*)g.Bt + (size_t)cur.pn * tstep;
    S.a_ready(cur);
    if constexpr (SP2) {
        PG8_STAGE(PG8_SB(0, 0), cB, voffB); PG8_STAGE(PG8_SB(0, 1), cB + hstep, voffB); PG8_STAGE_A(PG8_SA(0, 0), cA, cG); PG8_STAGE_A(PG8_SA(0, 1), cA + hstepA, cG);
        if (wr == 1) PG8_BAR;
        PG8_WAIT_V(2); PG8_BAR;
        PG8_STAGE(PG8_SB(1, 0), cB + kstep, voffB); PG8_STAGE_A(PG8_SA(1, 0), cA + kstep, cG); PG8_STAGE(PG8_SB(1, 1), cB + hstep + kstep, voffB);
        PG8_WAIT_V(6); PG8_BAR;
    } else {
        PG8_STAGE(PG8_SB(0, 0), cB, voffB); PG8_STAGE_A(PG8_SA(0, 0), cA, cG); PG8_STAGE(PG8_SB(0, 1), cB + hstep, voffB); PG8_STAGE_A(PG8_SA(0, 1), cA + hstepA, cG);
        if (wr == 1) PG8_BAR;
        PG8_WAIT_V(4); PG8_BAR;
        PG8_STAGE(PG8_SB(1, 0), cB + kstep, voffB); PG8_STAGE_A(PG8_SA(1, 0), cA + kstep, cG); PG8_STAGE(PG8_SB(1, 1), cB + hstep + kstep, voffB);
        PG8_WAIT_V(6); PG8_BAR;
    }
    for (;;) {
        const bool has_next = S.next(ui + 1, nxt);
        const char* nA = has_next ? PG8_ABASE(nxt.pm) : cA; const size_t nG = has_next ? PG8_AGAP(nxt.pm) : cG; const char* nB = has_next ? (const char*)g.Bt + (size_t)nxt.pn * tstep : cB;
#pragma unroll 1
        for (int t = 0; t < nt; t += 2) {
            const bool last = (t == nt - 2);
            const char* a1 = cA + (size_t)(t + 1) * kstep;
            const char* a2 = last ? nA : cA + (size_t)(t + 2) * kstep; const char* b2 = last ? nB : cB + (size_t)(t + 2) * kstep;
            const char* a3 = a2 + kstep; const char* b3 = b2 + kstep; const size_t g2 = last ? nG : cG;
            if (last && has_next) S.a_ready(nxt);
            if constexpr (SP2) {
            PG8_LDB(B0, 0, 0); PG8_LDB(B1, 0, 1); PG8_SCHED; PG8_LDA(At, 0, 0); PG8_STAGE_A(PG8_SA(1, 1), a1 + hstepA, cG);
            PG8_WAIT_V(8); PG8_WAIT_L(0); PG8_BAR; PG8_MMA(0, 0, At, B0); PG8_MMA(0, 1, At, B1); PG8_BAR; PG8_SCHED;
            PG8_LDA(At, 0, 1); PG8_STAGE(PG8_SB(0, 0), b2, voffB); PG8_STAGE(PG8_SB(0, 1), b2 + hstep, voffB); PG8_STAGE_A(PG8_SA(0, 0), a2, g2);
            PG8_WAIT_V(8); PG8_WAIT_L(0); PG8_BAR; PG8_MMA(1, 0, At, B0); PG8_MMA(1, 1, At, B1); PG8_BAR; PG8_SCHED;
            PG8_LDB(B0, 1, 0); PG8_LDB(B1, 1, 1); PG8_SCHED; PG8_LDA(At, 1, 0); PG8_STAGE_A(PG8_SA(0, 1), a2 + hstepA, g2);
            PG8_WAIT_V(8); PG8_WAIT_L(0); PG8_BAR; PG8_MMA(0, 0, At, B0); PG8_MMA(0, 1, At, B1); PG8_BAR; PG8_SCHED;
            PG8_LDA(At, 1, 1); PG8_STAGE(PG8_SB(1, 0), b3, voffB); PG8_STAGE(PG8_SB(1, 1), b3 + hstep, voffB); PG8_STAGE_A(PG8_SA(1, 0), a3, g2);
            PG8_WAIT_V(8); PG8_WAIT_L(0); PG8_BAR; PG8_MMA(1, 0, At, B0); PG8_MMA(1, 1, At, B1); PG8_BAR; PG8_SCHED;
            } else {
            PG8_LDB(B0, 0, 0); PG8_SCHED; PG8_LDA(At, 0, 0); PG8_STAGE_A(PG8_SA(1, 1), a1 + hstepA, cG);
            PG8_WAIT_L(8); PG8_BAR; PG8_WAIT_L(0); PG8_MMA(0, 0, At, B0); PG8_BAR; PG8_SCHED;
            PG8_LDB(B1, 0, 1); PG8_STAGE(PG8_SB(0, 0), b2, voffB);
            PG8_BAR; PG8_WAIT_L(0); PG8_MMA(0, 1, At, B1); PG8_BAR;
            PG8_LDA(At, 0, 1); PG8_STAGE_A(PG8_SA(0, 0), a2, g2);
            PG8_BAR; PG8_WAIT_L(0); PG8_MMA(1, 0, At, B0); PG8_BAR; PG8_SCHED;
            PG8_STAGE(PG8_SB(0, 1), b2 + hstep, voffB);
            PG8_WAIT_V(6); PG8_BAR; PG8_MMA(1, 1, At, B1); PG8_BAR;
            PG8_LDB(B0, 1, 0); PG8_SCHED; PG8_LDA(At, 1, 0); PG8_STAGE_A(PG8_SA(0, 1), a2 + hstepA, g2);
            PG8_WAIT_L(8); PG8_BAR; PG8_WAIT_L(0); PG8_MMA(0, 0, At, B0); PG8_BAR; PG8_SCHED;
            PG8_LDB(B1, 1, 1); PG8_STAGE(PG8_SB(1, 0), b3, voffB);
            PG8_BAR; PG8_WAIT_L(0); PG8_MMA(0, 1, At, B1); PG8_BAR;
            PG8_LDA(At, 1, 1); PG8_STAGE_A(PG8_SA(1, 0), a3, g2);
            PG8_BAR; PG8_WAIT_L(0); PG8_MMA(1, 0, At, B0); PG8_BAR; PG8_SCHED;
            PG8_STAGE(PG8_SB(1, 1), b3 + hstep, voffB);
            PG8_WAIT_V(6); PG8_BAR; PG8_MMA(1, 1, At, B1); PG8_BAR;
            }
        }
        if constexpr (ALIGN_EPI) { if (wr == 0) PG8_BAR; }
        E(acc, cur, wr, wc, fr, fq); S.done(cur);
        if (!has_next) break;
#pragma unroll
        for (int a = 0; a < 2; ++a)
#pragma unroll
            for (int b = 0; b < 2; ++b)
#pragma unroll
                for (int m = 0; m < 4; ++m)
#pragma unroll
                    for (int n = 0; n < 2; ++n) acc[a][b][m][n] = (f32x4){0.f, 0.f, 0.f, 0.f};
        cur = nxt; cA = nA; cG = nG; cB = nB; ++ui;
        if constexpr (ALIGN_EPI) { if (wr == 1) PG8_BAR; }
    }
    PG8_WAIT_V(0);
    if constexpr (!ALIGN_EPI) { if (wr == 0) PG8_BAR; }
    PG8_BAR;
#undef PG8_SA
#undef PG8_STAGE_A
#undef PG8_ABASE
#undef PG8_AGAP
#undef PG8_SB
#undef PG8_STAGE
#undef PG8_LDA
#undef PG8_LDB
#undef PG8_MMA
#undef PG8_WAIT_V
#undef PG8_WAIT_L
#undef PG8_BAR
#undef PG8_SCHED
}


struct EpiProj {
    static constexpr bool PERM = true;
    bf16_t* O; const float* r1; const float* gv;
    __device__ __forceinline__ void operator()(const f32x4 (&acc)[2][2][4][2], const Unit& u, int wr, int wc, int fr, int fq) const {
        const int row0 = u.pm * BM + wr * 64 + fr, pn = u.pn;
        const int mode = pn < 4 ? 0 : (pn < 6 ? 2 : (pn < 10 ? 4 : 3));
        if (mode == 2) {
            const int h = 4 * (pn - 4) + wc;
            f32x4 g[2][2];
#pragma unroll
            for (int bj = 0; bj < 2; ++bj)
#pragma unroll
                for (int n = 0; n < 2; ++n) g[bj][n] = *(const f32x4*)(gv + h * 64 + 32 * bj + 8 * fq + 4 * n);
#pragma unroll
            for (int ai = 0; ai < 2; ++ai)
#pragma unroll
                for (int m = 0; m < 4; ++m) {
                    const int row = row0 + ai * HALF + m * 16; const float rs = r1[row];
                    f32x4 v[2][2]; float ss = 0.f;
#pragma unroll
                    for (int bj = 0; bj < 2; ++bj)
#pragma unroll
                        for (int n = 0; n < 2; ++n) { v[bj][n] = gelu4(acc[ai][bj][m][n] * rs); const f32x4 q = v[bj][n] * v[bj][n]; ss += (q[0] + q[1]) + (q[2] + q[3]); }
                    ss += __shfl_xor(ss, 16); ss += __shfl_xor(ss, 32);
                    const float ri = __builtin_amdgcn_rsqf(ss * (1.0f / 64.0f) + EPS);
                    bf16_t* rowp = O + (size_t)row * DIN + pn * BM + 64 * wc + 8 * fq;
#pragma unroll
                    for (int bj = 0; bj < 2; ++bj) { const f32x4 a = v[bj][0] * ri * g[bj][0], b = v[bj][1] * ri * g[bj][1];
                        u32x4 w; w.x = cvt_pk_bf16(a[0], a[1]); w.y = cvt_pk_bf16(a[2], a[3]); w.z = cvt_pk_bf16(b[0], b[1]); w.w = cvt_pk_bf16(b[2], b[3]);
                        *(u32x4*)(rowp + 32 * bj) = w; }
                }
        } else {
#pragma unroll
            for (int ai = 0; ai < 2; ++ai)
#pragma unroll
                for (int m = 0; m < 4; ++m) {
                    const int row = row0 + ai * HALF + m * 16; const float rs = r1[row];
                    bf16_t* rowp = O + (size_t)row * DIN + pn * BM + 32 * wc + 8 * fq;
                    const float rq = (mode >= 3) ? rs * -1.44269504089f : rs;
#pragma unroll
                    for (int bj = 0; bj < 2; ++bj) { f32x4 a = acc[ai][bj][m][0] * rq, b = acc[ai][bj][m][1] * rq;
                        if (mode == 1) { a = gelu4(a); b = gelu4(b); } else if (mode == 3) { a = sigp4(a); b = sigp4(b); }
                        u32x4 w; w.x = cvt_pk_bf16(a[0], a[1]); w.y = cvt_pk_bf16(a[2], a[3]); w.z = cvt_pk_bf16(b[0], b[1]); w.w = cvt_pk_bf16(b[2], b[3]);
                        *(u32x4*)(rowp + HALF * bj) = w; }
                }
        }
    }
};

struct EpiMerge {
    static constexpr bool PERM = true;
    bf16_t* AG; const bf16_t* PROJ;
    __device__ __forceinline__ void operator()(const f32x4 (&acc)[2][2][4][2], const Unit& u, int wr, int wc, int fr, int fq) const {
        const int row0 = u.pm * BM + wr * 64 + fr, col0 = u.pn * BM + 32 * wc + 8 * fq;
#pragma unroll
        for (int ai = 0; ai < 2; ++ai)
#pragma unroll
            for (int m = 0; m < 4; ++m) {
                const int row = row0 + ai * HALF + m * 16;
#pragma unroll
                for (int bj = 0; bj < 2; ++bj) {
                    bf16_t* ap = AG + (size_t)row * D + col0 + HALF * bj;
                    const u32x4 a = *(const u32x4*)ap, g = *(const u32x4*)(PROJ + (size_t)row * DIN + 2560 + col0 + HALF * bj);
                    const f32x4 c0 = acc[ai][bj][m][0], c1 = acc[ai][bj][m][1];
                    u32x4 w;
                    w.x = cvt_pk_bf16(bf_lo(a.x) + bf_lo(g.x) * c0[0], bf_hi(a.x) + bf_hi(g.x) * c0[1]);
                    w.y = cvt_pk_bf16(bf_lo(a.y) + bf_lo(g.y) * c0[2], bf_hi(a.y) + bf_hi(g.y) * c0[3]);
                    w.z = cvt_pk_bf16(bf_lo(a.z) + bf_lo(g.z) * c1[0], bf_hi(a.z) + bf_hi(g.z) * c1[1]);
                    w.w = cvt_pk_bf16(bf_lo(a.w) + bf_lo(g.w) * c1[2], bf_hi(a.w) + bf_hi(g.w) * c1[3]);
                    *(u32x4*)ap = w; }
            }
    }
};

struct EpiRes {
    static constexpr bool PERM = true;
    bf16_t* xb; float* ssq;
    __device__ __forceinline__ void operator()(const f32x4 (&acc)[2][2][4][2], const Unit& u, int wr, int wc, int fr, int fq) const {
        const int row0 = u.pm * BM + wr * 64 + fr, col0 = u.pn * BM + 32 * wc + 8 * fq;
#pragma unroll
        for (int ai = 0; ai < 2; ++ai)
#pragma unroll
            for (int m = 0; m < 4; ++m) {
                const int row = row0 + ai * HALF + m * 16;
                bf16_t* rp = xb + (size_t)row * D + col0;
                float ss = 0.f;
#pragma unroll
                for (int bj = 0; bj < 2; ++bj) {
                    const u32x4 b = *(const u32x4*)(rp + HALF * bj);
                    const f32x4 c0 = acc[ai][bj][m][0], c1 = acc[ai][bj][m][1];
                    const float x0 = bf_lo(b.x) + c0[0], x1 = bf_hi(b.x) + c0[1], x2 = bf_lo(b.y) + c0[2], x3 = bf_hi(b.y) + c0[3];
                    const float x4 = bf_lo(b.z) + c1[0], x5 = bf_hi(b.z) + c1[1], x6 = bf_lo(b.w) + c1[2], x7 = bf_hi(b.w) + c1[3];
                    ss += ((x0 * x0 + x1 * x1) + (x2 * x2 + x3 * x3)) + ((x4 * x4 + x5 * x5) + (x6 * x6 + x7 * x7));
                    u32x4 w; w.x = cvt_pk_bf16(x0, x1); w.y = cvt_pk_bf16(x2, x3); w.z = cvt_pk_bf16(x4, x5); w.w = cvt_pk_bf16(x6, x7);
                    *(u32x4*)(rp + HALF * bj) = w; }
                ss += __shfl_xor(ss, 16); ss += __shfl_xor(ss, 32);
                if (fq == 0) (void)__hip_atomic_fetch_add(ssq + row, ss, __ATOMIC_RELAXED, __HIP_MEMORY_SCOPE_AGENT);
            }
    }
};

__device__ __forceinline__ float dpp_ror1(float v) { return __int_as_float(__builtin_amdgcn_update_dpp(__float_as_int(v), __float_as_int(v), 0x121, 0xf, 0xf, false)); }
__device__ __forceinline__ float dpp_ror15(float v) { return __int_as_float(__builtin_amdgcn_update_dpp(__float_as_int(v), __float_as_int(v), 0x12F, 0xf, 0xf, false)); }
__device__ __forceinline__ f32x2 ror1_2(f32x2 v) { return (f32x2){dpp_ror1(v.x), dpp_ror1(v.y)}; }
__device__ __forceinline__ f32x2 ror15_2(f32x2 v) { return (f32x2){dpp_ror15(v.x), dpp_ror15(v.y)}; }
struct EpiUp {
    static constexpr bool PERM = true;
    bf16_t* G; const float* ssq2; const float* cw; const float* cb;
    struct CW { f32x2 g0, g1, g2, gb, v0, v1, v2, vb; };
    __device__ __forceinline__ void ldw(CW& w, int c) const {
        w.g0 = *(const f32x2*)(cw + c); w.g1 = *(const f32x2*)(cw + NUP + c); w.g2 = *(const f32x2*)(cw + 2 * NUP + c); w.gb = *(const f32x2*)(cb + c);
        w.v0 = *(const f32x2*)(cw + DFF + c); w.v1 = *(const f32x2*)(cw + NUP + DFF + c); w.v2 = *(const f32x2*)(cw + 2 * NUP + DFF + c); w.vb = *(const f32x2*)(cb + DFF + c); }
    static __device__ __forceinline__ float shr1(float v) { return __int_as_float(__builtin_amdgcn_update_dpp(0, __float_as_int(v), 0x111, 0xf, 0xf, true)); }
    static __device__ __forceinline__ float shl1(float v) { return __int_as_float(__builtin_amdgcn_update_dpp(0, __float_as_int(v), 0x101, 0xf, 0xf, true)); }
    __device__ __forceinline__ void operator()(const f32x4 (&acc)[2][2][4][2], const Unit& u, int wr, int wc, int fr, int fq) const {
        const int s_ = 2 * u.pm + wr, sg = s_ / 65, j = s_ - 65 * sg;
        const int tokb = 8192 * sg + 126 * j + 8 * fr;
        const int rlo = (j == 0) ? 0 : 1, rhi = (j == 64) ? 127 : 126;
        const bool mid = (j == 32) && (sg < 8), mz7 = mid && (fr == 7), mz8 = mid && (fr == 8);
        const int gcol = HALF * u.pn + 32 * wc + 8 * fq;
        CW wa, wb; ldw(wa, gcol);
        float rs[8];
#pragma unroll
        for (int blk = 0; blk < 8; ++blk) rs[blk] = __builtin_amdgcn_rsqf(ssq2[tokb + blk] * (1.0f / D) + EPS);
        unsigned outp[8][4];
        const f32x2 z2 = (f32x2){0.f, 0.f};
#pragma unroll
        for (int it = 0; it < 4; ++it) {
            const int n = it >> 1, ip = it & 1;
            if (it < 3) { if (it & 1) ldw(wa, gcol + 4 * ((it + 1) >> 1) + 2 * ((it + 1) & 1)); else ldw(wb, gcol + 4 * ((it + 1) >> 1) + 2 * ((it + 1) & 1)); }
            __builtin_amdgcn_sched_barrier(0);
            const CW& w = (it & 1) ? wb : wa;
#define UG(b_) ((f32x2){acc[(b_) >> 2][0][(b_) & 3][n][2 * ip], acc[(b_) >> 2][0][(b_) & 3][n][2 * ip + 1]} * rs[b_])
#define UV(b_) ((f32x2){acc[(b_) >> 2][1][(b_) & 3][n][2 * ip], acc[(b_) >> 2][1][(b_) & 3][n][2 * ip + 1]} * rs[b_])
            const f32x2 ug0 = UG(0), uv0 = UV(0), ug7 = UG(7), uv7 = UV(7);
            f32x2 pg = (f32x2){shr1(ug7.x), shr1(ug7.y)}, pv = (f32x2){shr1(uv7.x), shr1(uv7.y)};
            f32x2 eg = (f32x2){shl1(ug0.x), shl1(ug0.y)}, ev = (f32x2){shl1(uv0.x), shl1(uv0.y)};
            pg = mz8 ? z2 : pg; pv = mz8 ? z2 : pv; eg = mz7 ? z2 : eg; ev = mz7 ? z2 : ev;
            f32x2 cgu = ug0, cvu = uv0;
#pragma unroll
            for (int blk = 0; blk < 8; ++blk) {
                f32x2 ng, nv;
                if (blk < 7) { ng = UG(blk + 1); nv = UV(blk + 1); } else { ng = eg; nv = ev; }
                const f32x2 cgv = w.g2 * ng + (w.g1 * cgu + (w.g0 * pg + w.gb));
                const f32x2 cvv = w.v2 * nv + (w.v1 * cvu + (w.v0 * pv + w.vb));
                const f32x2 o = gelu_pk(cgv) * cvv;
                outp[blk][it] = cvt_pk_bf16(o.x, o.y);
                pg = cgu; pv = cvu; cgu = ng; cvu = nv;
            }
#undef UG
#undef UV
        }
#pragma unroll
        for (int blk = 0; blk < 8; ++blk) { const int rho = 8 * fr + blk;
            if (rho >= rlo && rho <= rhi) { u32x4 w4; w4.x = outp[blk][0]; w4.y = outp[blk][1]; w4.z = outp[blk][2]; w4.w = outp[blk][3];
                *(u32x4*)(G + (size_t)(tokb + blk) * DFF + gcol) = w4; } }
    }
};

struct EpiBf {
    static constexpr bool PERM = true;
    bf16_t* O;
    __device__ __forceinline__ void operator()(const f32x4 (&acc)[2][2][4][2], const Unit& u, int wr, int wc, int fr, int fq) const {
        const int row0 = u.pm * BM + wr * 64 + fr, col0 = u.pn * BM + 32 * wc + 8 * fq;
#pragma unroll
        for (int ai = 0; ai < 2; ++ai)
#pragma unroll
            for (int m = 0; m < 4; ++m) { bf16_t* rowp = O + (size_t)(row0 + ai * HALF + m * 16) * D + col0;
#pragma unroll
                for (int bj = 0; bj < 2; ++bj) { const f32x4 a = acc[ai][bj][m][0], b = acc[ai][bj][m][1];
                    u32x4 w; w.x = cvt_pk_bf16(a[0], a[1]); w.y = cvt_pk_bf16(a[2], a[3]); w.z = cvt_pk_bf16(b[0], b[1]); w.w = cvt_pk_bf16(b[2], b[3]);
                    *(u32x4*)(rowp + HALF * bj) = w; }
                asm volatile("" ::: "memory"); }
    }
};

struct EpiPg {
    static constexpr bool PERM = true;
    const bf16_t* X2; const bf16_t* PEMB; float* out; const float* ssq3; float* ssq4; unsigned* cnt; const float* gf;
    __device__ __forceinline__ void operator()(const f32x4 (&acc)[2][2][4][2], const Unit& u, int wr, int wc, int fr, int fq) const {
        const int row0 = u.pm * BM + wr * 64 + fr, col0 = u.pn * BM + 32 * wc + 8 * fq;
        f32x4 x[2][4][2][2];
#pragma unroll
        for (int ai = 0; ai < 2; ++ai)
#pragma unroll
            for (int m = 0; m < 4; ++m) {
                const int row = row0 + ai * HALF + m * 16;
                const float r3 = __builtin_amdgcn_rsqf(ssq3[row] * (1.0f / D) + EPS) * -1.44269504089f;
                float ss = 0.f;
#pragma unroll
                for (int bj = 0; bj < 2; ++bj) {
                    const size_t off = (size_t)row * D + col0 + HALF * bj;
                    const u32x4 pe = *(const u32x4*)(PEMB + off), b = *(const u32x4*)(X2 + off);
                    const f32x4 g0 = sigp4(acc[ai][bj][m][0] * r3), g1 = sigp4(acc[ai][bj][m][1] * r3);
                    const f32x4 a0 = (f32x4){bf_lo(b.x) + bf_lo(pe.x) * g0[0], bf_hi(b.x) + bf_hi(pe.x) * g0[1], bf_lo(b.y) + bf_lo(pe.y) * g0[2], bf_hi(b.y) + bf_hi(pe.y) * g0[3]};
                    const f32x4 a1 = (f32x4){bf_lo(b.z) + bf_lo(pe.z) * g1[0], bf_hi(b.z) + bf_hi(pe.z) * g1[1], bf_lo(b.w) + bf_lo(pe.w) * g1[2], bf_hi(b.w) + bf_hi(pe.w) * g1[3]};
                    x[ai][m][bj][0] = a0; x[ai][m][bj][1] = a1;
                    const f32x4 q0 = a0 * a0, q1 = a1 * a1; ss += ((q0[0] + q0[1]) + (q0[2] + q0[3])) + ((q1[0] + q1[1]) + (q1[2] + q1[3])); }
                ss += __shfl_xor(ss, 16); ss += __shfl_xor(ss, 32);
                if (fq == 0) (void)__hip_atomic_fetch_add(ssq4 + row, ss, __ATOMIC_RELAXED, __HIP_MEMORY_SCOPE_AGENT);
            }
        asm volatile("s_waitcnt vmcnt(0)" ::: "memory");
        unsigned* c = cnt + 64 * u.pm;
        if ((threadIdx.x & 63) == 0) (void)__hip_atomic_fetch_add(c, 1u, __ATOMIC_RELAXED, __HIP_MEMORY_SCOPE_AGENT);
        { unsigned sp = 0;
            while ((unsigned)__builtin_amdgcn_readfirstlane(__hip_atomic_load(c, __ATOMIC_RELAXED, __HIP_MEMORY_SCOPE_AGENT)) < 32u) { __builtin_amdgcn_s_sleep(8); if (++sp > (1u << 17)) break; } }
        f32x4 g[2][2];
#pragma unroll
        for (int bj = 0; bj < 2; ++bj) { g[bj][0] = *(const f32x4*)(gf + col0 + HALF * bj); g[bj][1] = *(const f32x4*)(gf + col0 + HALF * bj + 4); }
#pragma unroll
        for (int ai = 0; ai < 2; ++ai)
#pragma unroll
            for (int m = 0; m < 4; ++m) {
                const int row = row0 + ai * HALF + m * 16;
                const float r4 = __builtin_amdgcn_rsqf(__hip_atomic_load(ssq4 + row, __ATOMIC_RELAXED, __HIP_MEMORY_SCOPE_AGENT) * (1.0f / D) + EPS);
#pragma unroll
                for (int bj = 0; bj < 2; ++bj) { float* op = out + (size_t)row * D + col0 + HALF * bj;
                    *(f32x4*)op = x[ai][m][bj][0] * r4 * g[bj][0]; *(f32x4*)(op + 4) = x[ai][m][bj][1] * r4 * g[bj][1]; }
            }
    }
};
}

#define XB_TMO      128
#define XB_XCNT(j)  (256  + 64 * (j))
#define XB_XSUB(j)  (1280 + 64 * (j))
#define XB_XGEN(j)  (2304 + 64 * (j))
#define XB_TOP      3328
#define XB_TOPGEN   3392
#define XCD_BAR_WORDS 3456
#define XB_SPIN_CAP (1u << 18)
__device__ __forceinline__ unsigned xb_ld(unsigned* p)              { return __hip_atomic_load(p, __ATOMIC_RELAXED, __HIP_MEMORY_SCOPE_AGENT); }
__device__ __forceinline__ unsigned xb_add(unsigned* p, unsigned v) { return __hip_atomic_fetch_add(p, v, __ATOMIC_RELAXED, __HIP_MEMORY_SCOPE_AGENT); }
__device__ __forceinline__ unsigned xb_xcc_id() { return (unsigned)__builtin_amdgcn_s_getreg((3 << 11) | 20) & 0xFu; }
#define XB_SPIN(cond, bar) do { unsigned _sp = 0; while (cond) { __builtin_amdgcn_s_sleep(1); \
    if ((++_sp & 255u) == 0u) { if (xb_ld(&(bar)[XB_TMO])) break; if (_sp > XB_SPIN_CAP) { atomicAdd(&(bar)[XB_TMO], 1u); break; } } } } while (0)
struct XcdBarrier { unsigned* bar; unsigned x; volatile LAS unsigned* st; };
__device__ __forceinline__ XcdBarrier xcd_barrier_post(unsigned* bar, volatile LAS unsigned* st) {
    XcdBarrier b; b.bar = bar; b.x = xb_xcc_id(); b.st = st;
    if (threadIdx.x == 0) (void)xb_add(&bar[XB_XCNT(b.x)], 1u);
    return b;
}
__device__ __forceinline__ void xcd_barrier_complete(unsigned* bar, unsigned x, unsigned& nloc, unsigned& nx) {
    const unsigned G = gridDim.x * gridDim.y * gridDim.z;
    unsigned sum, cnt, mine, sp = 0u;
    for (;;) {
        sum = 0u; cnt = 0u; mine = 0u;
#pragma unroll
        for (unsigned j = 0; j < 16; ++j) { const unsigned c = xb_ld(&bar[XB_XCNT(j)]); sum += c; cnt += (c > 0u) ? 1u : 0u; mine = (j == x) ? c : mine; }
        if (sum == G) break;
        __builtin_amdgcn_s_sleep(1);
        if ((++sp & 255u) == 0u) { if (xb_ld(&bar[XB_TMO])) break; if (sp > XB_SPIN_CAP) { atomicAdd(&bar[XB_TMO], 1u); break; } }
    }
    nloc = mine > 0u ? mine : 1u; nx = cnt > 0u ? cnt : 1u;
}
__device__ __forceinline__ void xcd_barrier(const XcdBarrier& b) {
    asm volatile("s_waitcnt vmcnt(0)" ::: "memory");
    __syncthreads();
    if (threadIdx.x == 0) {
        unsigned* bar = b.bar;
        __builtin_amdgcn_s_waitcnt(0);
        unsigned nloc = b.st[0], nx = b.st[1];
        if (nloc == 0u) { xcd_barrier_complete(bar, b.x, nloc, nx); b.st[0] = nloc; b.st[1] = nx; }
        const unsigned old = xb_add(&bar[XB_XSUB(b.x)], 1u);
        const unsigned gen = old / nloc;
        if (old + 1u == (gen + 1u) * nloc) {
            __builtin_amdgcn_fence(__ATOMIC_RELEASE, "agent");
            asm volatile("s_waitcnt vmcnt(0)" ::: "memory");
            const unsigned og = xb_add(&bar[XB_TOP], 1u);
            const unsigned tg = og / nx;
            if (og + 1u == (tg + 1u) * nx) xb_add(&bar[XB_TOPGEN], 1u);
            else XB_SPIN(xb_ld(&bar[XB_TOPGEN]) == tg, bar);
            __builtin_amdgcn_fence(__ATOMIC_ACQUIRE, "agent");
            xb_add(&bar[XB_XGEN(b.x)], 1u);
            asm volatile("s_waitcnt vmcnt(0)" ::: "memory");
        } else {
            XB_SPIN(xb_ld(&bar[XB_XGEN(b.x)]) == gen, bar);
            __builtin_amdgcn_fence(__ATOMIC_ACQUIRE, "agent");
            asm volatile("s_waitcnt vmcnt(0)" ::: "memory");
        }
    }
    __syncthreads();
}

constexpr int NWAVES = 8, NTHR = 512;
constexpr int LDS_BYTES = 147456;
struct Args { const float* in[22]; float* out; unsigned char* ws; int ph_lo, ph_hi; };
using pg8::cvt_pk_bf16; using pg8::bf_lo; using pg8::bf_hi;

__device__ __forceinline__ float wave_sum(float v) {
#pragma unroll
    for (int o = 1; o < 64; o <<= 1) v += __shfl_xor(v, o);
    return v;
}
__device__ __forceinline__ void tr_item(const float* W, int K, int N, bf16_t* WT, int prow0, const float* gk, LAS float* scr, int k0, int n0, int lane) {
    float tv[32];
#pragma unroll
    for (int i = 0; i < 32; ++i) { const int kk = 2 * i + (lane >> 5); tv[i] = W[(size_t)(k0 + kk) * N + n0 + (lane & 31)]; }
    const float gsc = gk ? gk[k0 + lane] : 1.0f;
#pragma unroll
    for (int i = 0; i < 32; ++i) { const int kk = 2 * i + (lane >> 5); scr[kk * 33 + (lane & 31)] = tv[i] * __shfl(gsc, kk); }
    asm volatile("s_waitcnt lgkmcnt(0)" ::: "memory");
    const int c = lane & 7;
#pragma unroll
    for (int j = 0; j < 4; ++j) { const int n = (lane >> 3) + 8 * j; const LAS float* s = scr + (8 * c) * 33 + n;
        u32x4 o; o.x = cvt_pk_bf16(s[0 * 33], s[1 * 33]); o.y = cvt_pk_bf16(s[2 * 33], s[3 * 33]); o.z = cvt_pk_bf16(s[4 * 33], s[5 * 33]); o.w = cvt_pk_bf16(s[6 * 33], s[7 * 33]);
        *(u32x4*)(WT + (size_t)(prow0 + n) * K + k0 + 8 * c) = o; }
    asm volatile("s_waitcnt lgkmcnt(0)" ::: "memory");
}

__device__ __forceinline__ void p0_prologue(const Args& a, LAS unsigned char* lds, int wave, int lane) {
    unsigned char* ws = a.ws;
    LAS float* scr = (LAS float*)(lds + wave * 16384);
    const int gw = blockIdx.x * NWAVES + wave, NGW = gridDim.x * NWAVES;
    constexpr int I_IN = 16 * 112, I_UP = 16 * 176, I_DN = 44 * 32, I_O = 16 * 32, I_PG = 16 * 32, I_PE = 4 * 32, I_GP = 8 * 32, I_POOL = 4 * 16;
    constexpr int NITEMS = I_IN + I_UP + I_DN + I_O + I_PG + I_PE + I_GP + I_POOL;
    for (int it = gw; it < NITEMS; it += NGW) {
        int r = it;
        if (r < I_IN) { const int kb = r / 112, nb = r % 112, n0 = 32 * nb; int p = n0;
            if (n0 >= 1024 && n0 < 1536) { const int l = n0 - 1024, tv = l >> 8, w = l & 255, wc = w >> 6, bj = (w >> 5) & 1; p = 1024 + 256 * tv + 128 * bj + 32 * wc; }
            tr_item(a.in[5], D, DIN, (bf16_t*)(ws + WS_WIN), p, a.in[4], scr, 64 * kb, n0, lane); continue; } r -= I_IN;
        if (r < I_UP) { const int kb = r / 176, nb = r % 176, n0 = 32 * nb; int p;
            if (n0 < DFF) p = 256 * (n0 >> 7) + (n0 & 127); else { const int l = n0 - DFF; p = 256 * (l >> 7) + 128 + (l & 127); }
            tr_item(a.in[14], D, NUP, (bf16_t*)(ws + WS_WUP), p, a.in[13], scr, 64 * kb, n0, lane); continue; } r -= I_UP;
        if (r < I_DN) { const int kb = r / 32, nb = r % 32; tr_item(a.in[17], DFF, D, (bf16_t*)(ws + WS_WDN), 32 * nb, nullptr, scr, 64 * kb, 32 * nb, lane); continue; } r -= I_DN;
        if (r < I_O) { const int kb = r / 32, nb = r % 32; tr_item(a.in[12], D, D, (bf16_t*)(ws + WS_WO), 32 * nb, nullptr, scr, 64 * kb, 32 * nb, lane); continue; } r -= I_O;
        if (r < I_PG) { const int kb = r / 32, nb = r % 32; tr_item(a.in[20], D, D, (bf16_t*)(ws + WS_WPG), 32 * nb, a.in[18], scr, 64 * kb, 32 * nb, lane); continue; } r -= I_PG;
        if (r < I_PE) { const int kb = r / 32, nb = r % 32; tr_item(a.in[19], PLE, D, (bf16_t*)(ws + WS_WPE), 32 * nb, nullptr, scr, 64 * kb, 32 * nb, lane); continue; } r -= I_PE;
        if (r < I_GP) { const int kb = r / 32, nb = r % 32; tr_item(a.in[11], 512, D, (bf16_t*)(ws + WS_WGP), 32 * nb, nullptr, scr, 64 * kb, 32 * nb, lane); continue; } r -= I_GP;
        { const int g = r >> 4, rr = r & 15, kb = rr >> 3, nb = rr & 7;
          tr_item(a.in[6] + (size_t)g * 128 * 256, 128, 256, (bf16_t*)(ws + WS_POOLT) + (size_t)g * 256 * 128, 32 * nb, nullptr, scr, 64 * kb, 32 * nb, lane); }
    }
    if (gw == 0) for (int i = lane; i < 320; i += 64) ((unsigned*)(ws + WS_CNT))[64 * i] = 0u;
    for (int it = gw; it < 512; it += NGW) { const f32x4 v = *(const f32x4*)(a.in[9] + (size_t)it * 256 + lane * 4);
        u32x2 w; w.x = cvt_pk_bf16(v[0], v[1]); w.y = cvt_pk_bf16(v[2], v[3]); *(u32x2*)((bf16_t*)(ws + WS_SGUW) + (size_t)it * 256 + lane * 4) = w; }
    float* r1 = (float*)(ws + WS_R1); float* s2 = (float*)(ws + WS_SSQ2); float* s3 = (float*)(ws + WS_SSQ3); float* s4 = (float*)(ws + WS_SSQ4);
    bf16_t* XB = (bf16_t*)(ws + WS_XB); bf16_t* PB = (bf16_t*)(ws + WS_PB);
    for (int m0 = gw; m0 < T; m0 += 2 * NGW) {
        const int m1 = m0 + NGW; const bool two = m1 < T; const int mm1 = two ? m1 : m0;
        const float* xr0 = m0 < TP ? a.in[0] + (size_t)m0 * D : a.in[1] + (size_t)(m0 - TP) * D;
        const float* pr0 = m0 < TP ? a.in[2] + (size_t)m0 * PLE : a.in[3] + (size_t)(m0 - TP) * PLE;
        const float* xr1 = mm1 < TP ? a.in[0] + (size_t)mm1 * D : a.in[1] + (size_t)(mm1 - TP) * D;
        const float* pr1 = mm1 < TP ? a.in[2] + (size_t)mm1 * PLE : a.in[3] + (size_t)(mm1 - TP) * PLE;
        f32x4 v0[4], v1[4];
#pragma unroll
        for (int j = 0; j < 4; ++j) { v0[j] = *(const f32x4*)(xr0 + 256 * j + 4 * lane); v1[j] = *(const f32x4*)(xr1 + 256 * j + 4 * lane); }
        const f32x4 pv0 = *(const f32x4*)(pr0 + 4 * lane), pv1 = *(const f32x4*)(pr1 + 4 * lane);
        float s0 = 0.f, s1 = 0.f;
#pragma unroll
        for (int j = 0; j < 4; ++j) { const f32x4 q0 = v0[j] * v0[j], q1 = v1[j] * v1[j]; s0 += (q0[0] + q0[1]) + (q0[2] + q0[3]); s1 += (q1[0] + q1[1]) + (q1[2] + q1[3]); }
        s0 = wave_sum(s0); s1 = wave_sum(s1);
#pragma unroll
        for (int j = 0; j < 4; ++j) { u32x2 w; w.x = cvt_pk_bf16(v0[j][0], v0[j][1]); w.y = cvt_pk_bf16(v0[j][2], v0[j][3]); *(u32x2*)(XB + (size_t)m0 * D + 256 * j + 4 * lane) = w; }
        { u32x2 w; w.x = cvt_pk_bf16(pv0[0], pv0[1]); w.y = cvt_pk_bf16(pv0[2], pv0[3]); *(u32x2*)(PB + (size_t)m0 * PLE + 4 * lane) = w; }
        if (lane == 0) { r1[m0] = __builtin_amdgcn_rsqf(s0 * (1.0f / D) + EPS); s2[m0] = 0.f; s3[m0] = 0.f; s4[m0] = 0.f; }
        if (two) {
#pragma unroll
            for (int j = 0; j < 4; ++j) { u32x2 w; w.x = cvt_pk_bf16(v1[j][0], v1[j][1]); w.y = cvt_pk_bf16(v1[j][2], v1[j][3]); *(u32x2*)(XB + (size_t)m1 * D + 256 * j + 4 * lane) = w; }
            { u32x2 w; w.x = cvt_pk_bf16(pv1[0], pv1[1]); w.y = cvt_pk_bf16(pv1[2], pv1[3]); *(u32x2*)(PB + (size_t)m1 * PLE + 4 * lane) = w; }
            if (lane == 0) { r1[m1] = __builtin_amdgcn_rsqf(s1 * (1.0f / D) + EPS); s2[m1] = 0.f; s3[m1] = 0.f; s4[m1] = 0.f; }
        }
    }
}

struct P2Stage { u32x4 z[5]; u32x4 v[2][2]; };
__device__ __forceinline__ void p2_fetch(P2Stage& st, const bf16_t* PROJ, int uid, int tid, int wave, int lane) {
    const int chunk = uid >> 2, q = uid & 3, t0 = chunk * 128;
    const int seqmask = t0 < TP ? 4095 : 8191;
    const bool at_start = (t0 & seqmask) == 0, at_end = ((t0 + 128) & seqmask) == 0;
#pragma unroll
    for (int k = 0; k < 5; ++k) { const int p = tid + NTHR * k; const int r = p >> 4, o = p & 15; const int t = t0 - 8 + r;
        const bool ok = (p < 144 * 16) && !((r < 8 && at_start) || (r >= 136 && at_end));
        st.z[k] = (u32x4){0u, 0u, 0u, 0u}; if (ok) st.z[k] = *(const u32x4*)(PROJ + (size_t)t * DIN + 128 * q + 8 * o); }
#pragma unroll
    for (int h2 = 0; h2 < 2; ++h2) { const bf16_t* src = PROJ + (size_t)(t0 + 2 * lane) * DIN + 1024 + 64 * (2 * q + h2) + 8 * wave;
        st.v[h2][0] = *(const u32x4*)src; st.v[h2][1] = *(const u32x4*)(src + DIN); }
}
__device__ __forceinline__ void p2_mixers(const Args& a, LAS unsigned char* lds, int tid, int wave, int lane) {
    unsigned char* ws = a.ws;
    const bf16_t* PROJ = (const bf16_t*)(ws + WS_PROJ); bf16_t* AG = (bf16_t*)(ws + WS_MG); bf16_t* GATED = (bf16_t*)a.out;
    const bf16_t* POOLT = (const bf16_t*)(ws + WS_POOLT); const bf16_t* SGUW = (const bf16_t*)(ws + WS_SGUW);
    const float* pool_scale = a.in[7]; const float* sgu_b = a.in[10];
    LAS unsigned char* zt = lds; LAS unsigned char* dt = lds + 36864; LAS unsigned char* vt = lds + 36864 + 34816;
    const int fr = lane & 15, fq = lane >> 4;
    P2Stage st;
    if ((int)blockIdx.x < 2560) p2_fetch(st, PROJ, blockIdx.x, tid, wave, lane);
    for (int uid = blockIdx.x; uid < 2560; uid += gridDim.x) {
        const int chunk = uid >> 2, q = uid & 3, t0 = chunk * 128;
        const int seqmask = t0 < TP ? 4095 : 8191;
        const bool at_start = (t0 & seqmask) == 0, at_end = ((t0 + 128) & seqmask) == 0;
#pragma unroll
        for (int k = 0; k < 5; ++k) { const int p = tid + NTHR * k; if (p < 144 * 16) *(LAS u32x4*)(zt + (p >> 4) * 256 + (p & 15) * 16) = st.z[k]; }
#pragma unroll
        for (int h2 = 0; h2 < 2; ++h2) { const u32x4 v0 = st.v[h2][0], v1 = st.v[h2][1];
            LAS unsigned char* dst = vt + (h2 * 64 + 8 * wave) * 272 + 4 * lane;
            *(LAS unsigned*)(dst + 0 * 272) = (v0.x & 0xffffu) | (v1.x << 16); *(LAS unsigned*)(dst + 1 * 272) = (v0.x >> 16) | (v1.x & 0xffff0000u);
            *(LAS unsigned*)(dst + 2 * 272) = (v0.y & 0xffffu) | (v1.y << 16); *(LAS unsigned*)(dst + 3 * 272) = (v0.y >> 16) | (v1.y & 0xffff0000u);
            *(LAS unsigned*)(dst + 4 * 272) = (v0.z & 0xffffu) | (v1.z << 16); *(LAS unsigned*)(dst + 5 * 272) = (v0.z >> 16) | (v1.z & 0xffff0000u);
            *(LAS unsigned*)(dst + 6 * 272) = (v0.w & 0xffffu) | (v1.w << 16); *(LAS unsigned*)(dst + 7 * 272) = (v0.w >> 16) | (v1.w & 0xffff0000u); }
        bf16x8 wf[2][4], sf[2][4];
        const int h2w = wave >> 2, ts = 32 * (wave & 3), hh = 2 * q + h2w;
#pragma unroll
        for (int nb = 0; nb < 2; ++nb)
#pragma unroll
            for (int ks = 0; ks < 4; ++ks) { const int row = 32 * wave + 8 * (fr >> 2) + 4 * nb + (fr & 3);
                wf[nb][ks] = *(const bf16x8*)(POOLT + ((size_t)(q * 256 + row)) * 128 + 32 * ks + 8 * fq); }
        const int col = 256 * q + 32 * wave + 8 * fq;
        u32x4 gg[8], uu[2][2]; float bb[2];
#pragma unroll
        for (int mb = 0; mb < 8; ++mb) gg[mb] = *(const u32x4*)(PROJ + (size_t)(t0 + 16 * mb + fr) * DIN + 1536 + col);
        __syncthreads();
        { const int half = 1 << q, tau0 = 16 * wave; const LAS unsigned* zd = (const LAS unsigned*)zt; LAS unsigned* dd = (LAS unsigned*)dt;
            float s0 = 0.f, s1 = 0.f;
            for (int r = tau0 + 8 - half; r < tau0 + 8 + half; ++r) { const unsigned w = zd[r * 64 + lane]; s0 += bf_lo(w); s1 += bf_hi(w); }
#pragma unroll 4
            for (int k = 0; k < 16; ++k) { const int tau = tau0 + k;
                int cnt = 2 * half; if (at_start) { const int o = half - tau; cnt -= o > 0 ? o : 0; } if (at_end) { const int o = tau + half - 128; cnt -= o > 0 ? o : 0; }
                const float inv = 1.0f / (float)cnt;
                const unsigned wcn = zd[(tau + 8) * 64 + lane];
                dd[tau * 68 + lane] = cvt_pk_bf16(s0 * inv - bf_lo(wcn), s1 * inv - bf_hi(wcn));
                const unsigned wl = zd[(tau + 8 - half) * 64 + lane], wh = zd[(tau + 8 + half) * 64 + lane];
                s0 += bf_lo(wh) - bf_lo(wl); s1 += bf_hi(wh) - bf_hi(wl); }
        }
        __syncthreads();
        if (uid + (int)gridDim.x < 2560) p2_fetch(st, PROJ, uid + gridDim.x, tid, wave, lane);
        { f32x4 acc[8][2];
#pragma unroll
            for (int mb = 0; mb < 8; ++mb) { acc[mb][0] = (f32x4){0.f, 0.f, 0.f, 0.f}; acc[mb][1] = (f32x4){0.f, 0.f, 0.f, 0.f}; }
#pragma unroll
            for (int mb = 0; mb < 8; ++mb)
#pragma unroll
                for (int ks = 0; ks < 4; ++ks) { const bf16x8 df = *(const LAS bf16x8*)(dt + (16 * mb + fr) * 272 + (32 * ks + 8 * fq) * 2);
                    acc[mb][0] = __builtin_amdgcn_mfma_f32_16x16x32_bf16(wf[0][ks], df, acc[mb][0], 0, 0, 0);
                    acc[mb][1] = __builtin_amdgcn_mfma_f32_16x16x32_bf16(wf[1][ks], df, acc[mb][1], 0, 0, 0); }
#pragma unroll
            for (int mb = 0; mb < 2; ++mb)
#pragma unroll
                for (int ks = 0; ks < 4; ++ks) sf[mb][ks] = *(const bf16x8*)(SGUW + ((size_t)hh * 128 + ts + 16 * mb + fr) * 128 + 32 * ks + 8 * fq);
#pragma unroll
            for (int mb = 0; mb < 2; ++mb) { const int tau = ts + 16 * mb + fr; bb[mb] = sgu_b[hh * 128 + tau];
#pragma unroll
                for (int hf = 0; hf < 2; ++hf) uu[mb][hf] = *(const u32x4*)(PROJ + (size_t)(t0 + tau) * DIN + 512 + 64 * hh + 32 * hf + 8 * fq); }
            const f32x4 sc0 = *(const f32x4*)(pool_scale + col), sc1 = *(const f32x4*)(pool_scale + col + 4);
#pragma unroll
            for (int mb = 0; mb < 8; ++mb) { const size_t t = (size_t)(t0 + 16 * mb + fr);
                const u32x4 g = gg[mb];
                const f32x4 x0 = acc[mb][0] * sc0, x1 = acc[mb][1] * sc1;
                u32x4 w; w.x = cvt_pk_bf16(x0[0] * pg8::sigp(bf_lo(g.x)), x0[1] * pg8::sigp(bf_hi(g.x))); w.y = cvt_pk_bf16(x0[2] * pg8::sigp(bf_lo(g.y)), x0[3] * pg8::sigp(bf_hi(g.y)));
                w.z = cvt_pk_bf16(x1[0] * pg8::sigp(bf_lo(g.z)), x1[1] * pg8::sigp(bf_hi(g.z))); w.w = cvt_pk_bf16(x1[2] * pg8::sigp(bf_lo(g.w)), x1[3] * pg8::sigp(bf_hi(g.w)));
                *(u32x4*)(AG + t * D + col) = w; }
        }
        { f32x4 acc[2][4];
#pragma unroll
            for (int mb = 0; mb < 2; ++mb)
#pragma unroll
                for (int nb = 0; nb < 4; ++nb) acc[mb][nb] = (f32x4){0.f, 0.f, 0.f, 0.f};
#pragma unroll
            for (int nb = 0; nb < 4; ++nb)
#pragma unroll
                for (int ks = 0; ks < 4; ++ks) { const int crow = 32 * (nb >> 1) + 8 * (fr >> 2) + 4 * (nb & 1) + (fr & 3);
                    const bf16x8 vf = *(const LAS bf16x8*)(vt + (h2w * 64 + crow) * 272 + (32 * ks + 8 * fq) * 2);
                    acc[0][nb] = __builtin_amdgcn_mfma_f32_16x16x32_bf16(vf, sf[0][ks], acc[0][nb], 0, 0, 0);
                    acc[1][nb] = __builtin_amdgcn_mfma_f32_16x16x32_bf16(vf, sf[1][ks], acc[1][nb], 0, 0, 0); }
#pragma unroll
            for (int mb = 0; mb < 2; ++mb) { const int tau = ts + 16 * mb + fr; const size_t t = (size_t)(t0 + tau); const float b = bb[mb];
#pragma unroll
                for (int hf = 0; hf < 2; ++hf) { const int cb_ = 64 * hh + 32 * hf + 8 * fq;
                    const u32x4 u_ = uu[mb][hf];
                    const f32x4 x0 = acc[mb][2 * hf] + b, x1 = acc[mb][2 * hf + 1] + b;
                    const f32x2 ua = pg8::gelu_pk((f32x2){bf_lo(u_.x), bf_hi(u_.x)}), ub = pg8::gelu_pk((f32x2){bf_lo(u_.y), bf_hi(u_.y)});
                    const f32x2 uc = pg8::gelu_pk((f32x2){bf_lo(u_.z), bf_hi(u_.z)}), ud = pg8::gelu_pk((f32x2){bf_lo(u_.w), bf_hi(u_.w)});
                    u32x4 w; w.x = cvt_pk_bf16(x0[0] * ua.x, x0[1] * ua.y); w.y = cvt_pk_bf16(x0[2] * ub.x, x0[3] * ub.y);
                    w.z = cvt_pk_bf16(x1[0] * uc.x, x1[1] * uc.y); w.w = cvt_pk_bf16(x1[2] * ud.x, x1[3] * ud.y);
                    *(u32x4*)(GATED + t * 512 + cb_) = w; } }
        }
        __syncthreads();
    }
}

__global__ void __launch_bounds__(NTHR, 2) fwd_mega(Args a) {
    extern __shared__ __attribute__((aligned(16))) unsigned char lds_raw[];
    LAS unsigned char* lds = (LAS unsigned char*)lds_raw;
    cg::grid_group grid = cg::this_grid();
    const int tid = threadIdx.x, lane = tid & 63, wave = __builtin_amdgcn_readfirstlane(tid >> 6);
    const int G = gridDim.x, bx = blockIdx.x;
    unsigned char* ws = a.ws;
    const int lo = a.ph_lo, hi = a.ph_hi;
    volatile LAS unsigned* MISC = (volatile LAS unsigned*)(lds + 131072 + 1024);
    unsigned* barw = (unsigned*)(ws + WS_BAR);
    if (tid < 4) MISC[tid] = 0u;
    __syncthreads();
    XcdBarrier xbar = xcd_barrier_post(barw, MISC);
    if (lo < 0) grid.sync();
#define IN(k) (lo <= (k) && (k) < hi)
#define SEAM(k) do { if (IN(k) && IN((k) + 1)) xcd_barrier(xbar); } while (0)
    if (IN(0)) { p0_prologue(a, lds, wave, lane); } SEAM(0);
    if (IN(1)) { pg8::Gemm g{(const bf16_t*)(ws + WS_XB), (const bf16_t*)(ws + WS_WIN), D, 0}; pg8::StaticOrder S; S.init(T / 256, DIN / 256, G, bx);
        pg8::EpiProj E{(bf16_t*)(ws + WS_PROJ), (const float*)(ws + WS_R1), a.in[8]};
        pg8::gemm_phase<pg8::EpiProj, pg8::StaticOrder, true, true>(lds, g, S, E); } SEAM(1);
    if (IN(2)) { p2_mixers(a, lds, tid, wave, lane); } SEAM(2);
    if (IN(3)) { pg8::Gemm g{(const bf16_t*)a.out, (const bf16_t*)(ws + WS_WGP), 512, 0}; pg8::StaticOrder S; S.init(T / 256, D / 256, G, bx);
        pg8::EpiMerge E{(bf16_t*)(ws + WS_MG), (const bf16_t*)(ws + WS_PROJ)};
        pg8::gemm_phase<pg8::EpiMerge, pg8::StaticOrder, true, true>(lds, g, S, E); } SEAM(3);
    if (IN(4)) { pg8::Gemm g{(const bf16_t*)(ws + WS_MG), (const bf16_t*)(ws + WS_WO), D, 0}; pg8::StaticOrder S; S.init(T / 256, D / 256, G, bx);
        pg8::EpiRes E{(bf16_t*)(ws + WS_XB), (float*)(ws + WS_SSQ2)};
        pg8::gemm_phase<pg8::EpiRes, pg8::StaticOrder, true, true>(lds, g, S, E); } SEAM(4);
    if (IN(5)) { pg8::Gemm g{(const bf16_t*)(ws + WS_XB), (const bf16_t*)(ws + WS_WUP), D, 1}; pg8::StaticOrder S; S.init(325, NUP / 256, G, bx);
        pg8::EpiUp E{(bf16_t*)(ws + WS_PROJ), (const float*)(ws + WS_SSQ2), a.in[15], a.in[16]};
        pg8::gemm_phase<pg8::EpiUp, pg8::StaticOrder, true, true>(lds, g, S, E);
        pg8::Gemm g2{(const bf16_t*)(ws + WS_PB), (const bf16_t*)(ws + WS_WPE), PLE, 0}; pg8::StaticOrder S2; S2.init(T / 256, D / 256, G, bx);
        pg8::EpiBf E2{(bf16_t*)(ws + WS_MG)};
        pg8::gemm_phase<pg8::EpiBf, pg8::StaticOrder, true, true>(lds, g2, S2, E2); } SEAM(5);
    if (IN(6)) { pg8::Gemm g{(const bf16_t*)(ws + WS_PROJ), (const bf16_t*)(ws + WS_WDN), DFF, 0}; pg8::StaticOrder S; S.init(T / 256, D / 256, G, bx);
        pg8::EpiRes E{(bf16_t*)(ws + WS_XB), (float*)(ws + WS_SSQ3)};
        pg8::gemm_phase<pg8::EpiRes, pg8::StaticOrder, true, true>(lds, g, S, E); } SEAM(6);
    if (IN(7)) { pg8::Gemm g{(const bf16_t*)(ws + WS_XB), (const bf16_t*)(ws + WS_WPG), D, 0}; pg8::StaticOrder S; S.init(T / 256, D / 256, G, bx);
        pg8::EpiPg E{(const bf16_t*)(ws + WS_XB), (const bf16_t*)(ws + WS_MG), a.out, (const float*)(ws + WS_SSQ3), (float*)(ws + WS_SSQ4), (unsigned*)(ws + WS_CNT), a.in[21]};
        pg8::gemm_phase<pg8::EpiPg, pg8::StaticOrder, true, true>(lds, g, S, E); }
#undef IN
#undef SEAM
}

#ifndef MK_N_LAUNCHES
#define MK_N_LAUNCHES 1
#endif
extern "C" void kernel_launch(void* const* d_in, const int* in_sizes, int n_in, void* d_out, int out_size, void* d_ws, size_t ws_size, hipStream_t stream) {
    static int grid = 0;
    if (grid == 0) {
        if (n_in != 22 || out_size != T * D || ws_size < WS_END) { fprintf(stderr, "kernel_launch: unexpected shapes: n_in %d out %d ws %zu\n", n_in, out_size, ws_size); grid = -1; return; }
        int dev = 0, cus = 0, per_cu = 0;
        (void)hipGetDevice(&dev); (void)hipDeviceGetAttribute(&cus, hipDeviceAttributeMultiprocessorCount, dev);
        if (hipFuncSetAttribute((const void*)fwd_mega, hipFuncAttributeMaxDynamicSharedMemorySize, LDS_BYTES) != hipSuccess) { fprintf(stderr, "kernel_launch: hipFuncSetAttribute failed\n"); grid = -1; return; }
        if (hipOccupancyMaxActiveBlocksPerMultiprocessor(&per_cu, (const void*)fwd_mega, NTHR, LDS_BYTES) != hipSuccess || per_cu < 1) { fprintf(stderr, "kernel_launch: occupancy query says %d\n", per_cu); per_cu = 1; }
        (void)hipGetLastError();
        grid = cus * 1;
        if (grid <= 0) grid = 256;
    }
    if (grid < 0) return;
    if (hipMemsetAsync((char*)d_ws + WS_BAR, 0, XCD_BAR_WORDS * 4, stream) != hipSuccess) { fprintf(stderr, "kernel_launch: memset of the barrier words failed\n"); return; }
    Args a{};
    for (int i = 0; i < 22; ++i) a.in[i] = (const float*)d_in[i];
    a.out = (float*)d_out; a.ws = (unsigned char*)d_ws;
#if MK_N_LAUNCHES == 1
    a.ph_lo = 0; a.ph_hi = NPH;
    void* args[] = {&a};
    hipError_t e = hipLaunchCooperativeKernel((const void*)fwd_mega, dim3(grid), dim3(NTHR), args, LDS_BYTES, stream);
    if (e != hipSuccess) fprintf(stderr, "kernel_launch: cooperative launch failed: %s (grid %d)\n", hipGetErrorString(e), grid);
#endif
#ifdef PROBE_PHASE
    a.ph_lo = PROBE_PHASE; a.ph_hi = PROBE_PHASE + 1; hipLaunchKernelGGL(fwd_mega, dim3(grid), dim3(NTHR), LDS_BYTES, stream, a);
#endif
}
```
